# Optimizing an MI355X kernel written in HIP

```python
import jax
import jax.numpy as jnp
from jax import lax
import numpy as np

D_MODEL = 1024
BATCH = 2
SEQ = 8192
DEPTH = 2

GRID_W = 64
CTX_LEN = 256

H_A = 16
DH_A = 64
D_A = H_A * DH_A
WIN_H = 8
WIN_W = 16
ROPE_BASE = 10000.0

D_B = D_MODEL
NB_B = 16
BS_B = D_B // NB_B
CONV_W = 4
RG_C = 8.0

H_C = 16
N_C = 64
D_C = H_C * N_C
R_DECAY = 64
R_ICLR = 64
R_VRES = 32
R_GATE = 160
LNX_EPS = 64e-5

D_FF = 4 * D_MODEL
NORM_EPS = 1e-6
NEG_INF = -1e30

IN_WIDTHS = (D_A, D_A, D_A, D_B, D_B, D_C, D_C, D_C, D_MODEL, D_MODEL, D_MODEL)
N_IN = 3 * D_A + 2 * D_B + 3 * D_C + 3 * D_MODEL

kernel_name = 'hybrid_natten_rglru_rwkv7_dit_trunk'


def _rmsnorm(x, g):
    xf = x.astype(jnp.float32)
    y = xf * lax.rsqrt(jnp.mean(xf * xf, axis=-1, keepdims=True) + NORM_EPS)
    return (y * g.astype(jnp.float32)).astype(x.dtype)


def _split_in(z):
    return jnp.split(z, [int(s) for s in np.cumsum(IN_WIDTHS)[:-1]], axis=-1)


def _neighbour_mean(x):
    xp = jnp.pad(x, ((0, 0), (1, 1), (0, 0)))
    return 0.5 * (xp[:, :-2] + xp[:, 2:])


def _dwconv(x, w, b):
    pad_l = CONV_W // 2
    y = lax.conv_general_dilated(x, w[:, None, :].astype(x.dtype), window_strides=(1,),
                                 padding=[(pad_l, CONV_W - 1 - pad_l)],
                                 dimension_numbers=('NWC', 'WIO', 'NWC'),
                                 feature_group_count=x.shape[-1])
    return y + b


def _axial_rope(x, row, col):
    half = x.shape[-1] // 2
    nf = half // 2
    inv_freq = ROPE_BASE ** (-jnp.arange(nf, dtype=jnp.float32) / nf)

    def rotate(xp, pos):
        ang = pos.astype(jnp.float32)[:, None] * inv_freq
        cos = jnp.cos(ang)[None, :, None, :]
        sin = jnp.sin(ang)[None, :, None, :]
        x1 = xp[..., :nf].astype(jnp.float32)
        x2 = xp[..., nf:].astype(jnp.float32)
        return jnp.concatenate([x1 * cos - x2 * sin, x1 * sin + x2 * cos], axis=-1)

    return jnp.concatenate([rotate(x[..., :half], row), rotate(x[..., half:], col)], axis=-1).astype(x.dtype)


def _natten_mix(q, k, v, qc, kc, vc, rpb, ctx_out):
    B, L, H, dh = q.shape
    rows = L // GRID_W
    kh = min(WIN_H, rows)
    scale = dh ** -0.5
    f32 = jnp.float32
    t = jnp.arange(L)
    q = _axial_rope(q, t // GRID_W, t % GRID_W)
    k = _axial_rope(k, t // GRID_W, t % GRID_W)
    qg = q.reshape(B, rows, GRID_W, H, dh)
    kg = k.reshape(B, rows, GRID_W, H, dh)
    vg = v.reshape(B, rows, GRID_W, H, dh)
    col = jnp.arange(GRID_W)
    c0 = jnp.clip(col - WIN_W // 2, 0, GRID_W - WIN_W)
    in_win = (col[None, :] >= c0[:, None]) & (col[None, :] < c0[:, None] + WIN_W)
    dc_idx = jnp.clip(col[None, :] - col[:, None] + WIN_W - 1, 0, 2 * WIN_W - 2)

    def row_block(r):
        r0 = jnp.clip(r - kh // 2, 0, rows - kh)
        q_r = lax.dynamic_index_in_dim(qg, r, axis=1, keepdims=False)
        k_b = lax.dynamic_slice_in_dim(kg, r0, kh, axis=1)
        v_b = lax.dynamic_slice_in_dim(vg, r0, kh, axis=1)
        s_loc = jnp.einsum('bqhd,bikhd->bhqik', q_r, k_b, preferred_element_type=f32) * scale
        dr_idx = r0 + jnp.arange(kh) - r + WIN_H - 1
        bias = rpb[:, dr_idx][:, :, dc_idx].astype(f32)
        s_loc = jnp.where(in_win[:, None, :], s_loc + jnp.transpose(bias, (0, 2, 1, 3)), NEG_INF)
        s_ctx = jnp.einsum('bqhd,bchd->bhqc', q_r, kc, preferred_element_type=f32) * scale
        s_all = jnp.concatenate([s_loc.reshape(B, H, GRID_W, kh * GRID_W), s_ctx], axis=-1)
        p = jax.nn.softmax(s_all, axis=-1).astype(v.dtype)
        p_loc = p[..., :kh * GRID_W].reshape(B, H, GRID_W, kh, GRID_W)
        return (jnp.einsum('bhqik,bikhd->bqhd', p_loc, v_b)
                + jnp.einsum('bhqc,bchd->bqhd', p[..., kh * GRID_W:], vc))

    o = lax.map(row_block, jnp.arange(rows))
    y = jnp.transpose(o, (1, 0, 2, 3, 4)).reshape(B, L, H * dh)
    if not ctx_out:
        return y, None
    s = jnp.einsum('bqhd,bchd->bhqc', qc, kc, preferred_element_type=f32) * scale
    p = jax.nn.softmax(s, axis=-1).astype(vc.dtype)
    y_c = jnp.einsum('bhqc,bchd->bqhd', p, vc).reshape(B, qc.shape[1], H * dh)
    return y, y_c


def _rglru_gates(u, wa, ba, wx, bx, lam):
    B, L, D = u.shape
    ub = u.reshape(B, L, NB_B, BS_B)
    gr = jnp.einsum('blnd,nde->blne', ub, wa).reshape(B, L, D) + ba
    gi = jnp.einsum('blnd,nde->blne', ub, wx).reshape(B, L, D) + bx
    r = jax.nn.sigmoid(gr.astype(jnp.float32))
    i = jax.nn.sigmoid(gi.astype(jnp.float32))
    log_a = -RG_C * r * jax.nn.softplus(-lam.astype(jnp.float32))
    a = jnp.exp(log_a)
    b = jnp.sqrt(-jnp.expm1(2.0 * log_a)) * (i * u.astype(jnp.float32))
    return a, b


def _linear_scan(a, b, h0, reverse):
    def comb(lhs, rhs):
        return lhs[0] * rhs[0], rhs[0] * lhs[1] + rhs[1]
    a_cum, b_cum = lax.associative_scan(comb, (a, b), axis=1, reverse=reverse)
    return a_cum * h0[:, None, :] + b_cum


def _rglru_mix(u, ug, uc, ugc, lp, ctx_out):
    u = _dwconv(u, lp['conv_w'], lp['conv_b'])
    uc = _dwconv(uc, lp['conv_w'], lp['conv_b'])
    h_lat = 0.0
    h_ctx = 0.0
    for d, rev in enumerate((False, True)):
        gates = (lp['rg_wa'][d], lp['rg_ba'][d], lp['rg_wx'][d], lp['rg_bx'][d], lp['rg_lam'][d])
        a_c, b_c = _rglru_gates(uc, *gates)
        hc = _linear_scan(a_c, b_c, jnp.zeros_like(b_c[:, 0]), rev)
        h_last = hc[:, 0] if rev else hc[:, -1]
        a_l, b_l = _rglru_gates(u, *gates)
        h_lat = h_lat + _linear_scan(a_l, b_l, h_last, rev)
        if ctx_out:
            h_ctx = h_ctx + hc
    y = h_lat.astype(u.dtype) * jax.nn.gelu(ug)
    y_c = h_ctx.astype(uc.dtype) * jax.nn.gelu(ugc) if ctx_out else None
    return y, y_c


def _rwkv7_scan(S0, r, w, k, v, kk, a, reverse):
    def step(S, inp):
        r_t, w_t, k_t, v_t, kk_t, a_t = inp
        sa = jnp.einsum('bhvk,bhk->bhv', S, -kk_t)
        S = (S * w_t[:, :, None, :] + sa[..., None] * (kk_t * a_t)[:, :, None, :]
             + v_t[..., None] * k_t[:, :, None, :])
        return S, jnp.einsum('bhvk,bhk->bhv', S, r_t)
    xs = tuple(jnp.moveaxis(t, 1, 0) for t in (r, w, k, v, kk, a))
    S, y = lax.scan(step, S0, xs, reverse=reverse)
    return S, jnp.moveaxis(y, 0, 1)


def _rwkv7_seq(hh, r, k, v, v_first, lp, vres, states, need_out):
    B, L, _ = hh.shape
    f32 = jnp.float32
    xx = _neighbour_mean(hh) - hh
    mu = lp['rw_mu_h']
    xw = hh + xx * mu[0]
    xa = hh + xx * mu[1]
    xg = hh + xx * mu[2]
    if vres is None:
        v_first = v
    else:
        v0, v1, v2, mu_v = vres
        v = v + (v_first - v) * jax.nn.sigmoid(v0 + ((hh + xx * mu_v) @ v1) @ v2)

    def heads(t):
        return t.reshape(B, L, H_C, N_C)

    kk = heads((k * lp['rw_k_k']).astype(f32))
    kk = kk / jnp.maximum(jnp.sqrt(jnp.sum(kk * kk, axis=-1, keepdims=True)), 1e-12)
    rh = heads(r.astype(f32))
    vh = heads(v.astype(f32))
    y = jnp.zeros((B, L, H_C, N_C), f32)
    bonus = jnp.zeros((B, L, H_C, N_C), f32)
    new_states = []
    for d, rev in enumerate((False, True)):
        z = (lp['rw_w0'][d] + jnp.tanh(xw @ lp['rw_w1'][d]) @ lp['rw_w2'][d]).astype(f32)
        decay = jnp.exp(-jnp.exp(-jax.nn.softplus(-z) - 0.5))
        a = jax.nn.sigmoid((lp['rw_a0'][d] + (xa @ lp['rw_a1'][d]) @ lp['rw_a2'][d]).astype(f32))
        kd = heads(k.astype(f32) * (1.0 + (a - 1.0) * lp['rw_k_a']))
        S, yd = _rwkv7_scan(states[d], rh, heads(decay), kd, vh, kk, heads(a), rev)
        new_states.append(S)
        if need_out:
            y = y + yd
            bonus = bonus + jnp.sum(rh * kd * lp['rw_r_k'], axis=-1, keepdims=True) * vh
    if not need_out:
        return None, (new_states[0], new_states[1]), v_first
    mean = jnp.mean(y, axis=-1, keepdims=True)
    var = jnp.mean(jnp.square(y - mean), axis=-1, keepdims=True)
    yn = ((y - mean) * lax.rsqrt(var + LNX_EPS)).reshape(B, L, D_C) * lp['rw_ln_w'] + lp['rw_ln_b']
    g = jax.nn.sigmoid(xg @ lp['rw_g1']) @ lp['rw_g2']
    out = (yn + bonus.reshape(B, L, D_C)) * g
    return out.astype(hh.dtype), (new_states[0], new_states[1]), v_first


def _hybrid_mixer(h, hc, lp, vres, v_first, v_first_c, ctx_out):
    B = h.shape[0]
    qa, ka, va, ub, ug, rr, kr, vr, m_a, m_b, m_c = _split_in(h @ lp['w_in'])
    qac, kac, vac, ubc, ugc, rrc, krc, vrc, m_ac, m_bc, m_cc = _split_in(hc @ lp['w_in'])

    def heads_a(t):
        return t.reshape(t.shape[0], t.shape[1], H_A, DH_A)

    y_nat, y_nat_c = _natten_mix(heads_a(qa), heads_a(ka), heads_a(va),
                                 heads_a(qac), heads_a(kac), heads_a(vac), lp['rpb'], ctx_out)
    y_lru, y_lru_c = _rglru_mix(ub, ug, ubc, ugc, lp, ctx_out)

    mu = lp['rw_mu_rkv']

    def shift3(r_, k_, v_):
        return tuple(t + mu[j] * (_neighbour_mean(t) - t) for j, t in enumerate((r_, k_, v_)))

    zero = jnp.zeros((B, H_C, N_C, N_C), jnp.float32)
    r_c, k_c, v_c = shift3(rrc, krc, vrc)
    y_rw_c, states_c, v_first_c = _rwkv7_seq(hc, r_c, k_c, v_c, v_first_c, lp, vres, (zero, zero), ctx_out)
    r_l, k_l, v_l = shift3(rr, kr, vr)
    y_rw, _, v_first = _rwkv7_seq(h, r_l, k_l, v_l, v_first, lp, vres, states_c, True)

    def merge(ya, yb, yc, ga, gb, gc):
        mixed = (jax.nn.sigmoid(ga) * (ya @ lp['w_br_a'])
                 + jax.nn.sigmoid(gb) * (yb @ lp['w_br_b'])
                 + jax.nn.sigmoid(gc) * (yc @ lp['w_br_c']))
        return mixed @ lp['w_out']

    y = merge(y_nat, y_lru, y_rw, m_a, m_b, m_c)
    y_c = merge(y_nat_c, y_lru_c, y_rw_c, m_ac, m_bc, m_cc) if ctx_out else None
    return y, y_c, v_first, v_first_c


def _sqrelu_mlp(h, w1, w2):
    return jnp.square(jax.nn.relu(h @ w1)) @ w2


def setup_inputs(seed: int = 0) -> dict:
    key = jax.random.key(seed)
    ks = iter(jax.random.split(key, 64))
    f32 = jnp.float32
    D = D_MODEL

    def nrm(shape, scale):
        return scale * jax.random.normal(next(ks), shape, f32)

    def uni(shape, lo, hi):
        return jax.random.uniform(next(ks), shape, f32, lo, hi)

    inp = {}
    inp['x'] = nrm((BATCH, SEQ, D), 1.0)
    inp['c'] = nrm((BATCH, D), 1.0)
    inp['ctx'] = nrm((BATCH, CTX_LEN, D), 1.0)
    inp['c_ctx'] = nrm((D,), 1.0)
    inp['w_ada'] = nrm((DEPTH, D, 6 * D), 0.5 * D ** -0.5)
    inp['b_ada'] = nrm((DEPTH, 6 * D), 0.02)
    inp['norm1_g'] = 1.0 + nrm((DEPTH, D), 0.02)
    inp['norm2_g'] = 1.0 + nrm((DEPTH, D), 0.02)
    inp['w_in'] = nrm((DEPTH, D, N_IN), D ** -0.5)
    inp['rpb'] = nrm((DEPTH, H_A, 2 * WIN_H - 1, 2 * WIN_W - 1), 0.2)
    inp['conv_w'] = nrm((DEPTH, CONV_W, D_B), CONV_W ** -0.5)
    inp['conv_b'] = nrm((DEPTH, D_B), 0.02)
    inp['rg_wa'] = nrm((DEPTH, 2, NB_B, BS_B, BS_B), BS_B ** -0.5)
    inp['rg_ba'] = nrm((DEPTH, 2, D_B), 0.02)
    inp['rg_wx'] = nrm((DEPTH, 2, NB_B, BS_B, BS_B), BS_B ** -0.5)
    inp['rg_bx'] = nrm((DEPTH, 2, D_B), 0.02)
    a_base = uni((DEPTH, 2, D_B), 0.9 ** (1.0 / RG_C), 0.999 ** (1.0 / RG_C))
    inp['rg_lam'] = jnp.log(a_base) - jnp.log1p(-a_base)
    inp['rw_mu_rkv'] = uni((DEPTH, 3, D_C), 0.0, 1.0)
    inp['rw_mu_h'] = uni((DEPTH, 3, D), 0.0, 1.0)
    inp['rw_w0'] = uni((DEPTH, 2, D_C), -6.0, -1.0)
    inp['rw_w1'] = nrm((DEPTH, 2, D, R_DECAY), D ** -0.5)
    inp['rw_w2'] = nrm((DEPTH, 2, R_DECAY, D_C), 0.5 * R_DECAY ** -0.5)
    inp['rw_a0'] = nrm((DEPTH, 2, D_C), 0.1)
    inp['rw_a1'] = nrm((DEPTH, 2, D, R_ICLR), D ** -0.5)
    inp['rw_a2'] = nrm((DEPTH, 2, R_ICLR, D_C), 0.5 * R_ICLR ** -0.5)
    inp['rw_g1'] = nrm((DEPTH, D, R_GATE), D ** -0.5)
    inp['rw_g2'] = nrm((DEPTH, R_GATE, D_C), R_GATE ** -0.5)
    inp['rw_k_k'] = 0.85 + nrm((DEPTH, D_C), 0.02)
    inp['rw_k_a'] = 1.0 + nrm((DEPTH, D_C), 0.02)
    inp['rw_r_k'] = nrm((DEPTH, H_C, N_C), 0.1)
    inp['rw_ln_w'] = 1.0 + nrm((DEPTH, D_C), 0.02)
    inp['rw_ln_b'] = nrm((DEPTH, D_C), 0.02)
    inp['vres_v0'] = 1.0 + nrm((DEPTH - 1, D_C), 0.1)
    inp['vres_v1'] = nrm((DEPTH - 1, D, R_VRES), D ** -0.5)
    inp['vres_v2'] = nrm((DEPTH - 1, R_VRES, D_C), 0.5 * R_VRES ** -0.5)
    inp['vres_mu'] = uni((DEPTH - 1, D), 0.0, 1.0)
    inp['w_br_a'] = nrm((DEPTH, D_A, D), D_A ** -0.5)
    inp['w_br_b'] = nrm((DEPTH, D_B, D), D_B ** -0.5)
    inp['w_br_c'] = nrm((DEPTH, D_C, D), D_C ** -0.5)
    inp['w_out'] = nrm((DEPTH, D, D), D ** -0.5)
    inp['w_ff1'] = nrm((DEPTH, D, D_FF), D ** -0.5)
    inp['w_ff2'] = nrm((DEPTH, D_FF, D), D_FF ** -0.5)
    inp['final_g'] = 1.0 + nrm((D,), 0.02)
    return inp


def reference(x, c, ctx, c_ctx, w_ada, b_ada, norm1_g, norm2_g, w_in, rpb, conv_w, conv_b,
              rg_wa, rg_ba, rg_wx, rg_bx, rg_lam, rw_mu_rkv, rw_mu_h, rw_w0, rw_w1, rw_w2,
              rw_a0, rw_a1, rw_a2, rw_g1, rw_g2, rw_k_k, rw_k_a, rw_r_k, rw_ln_w, rw_ln_b,
              vres_v0, vres_v1, vres_v2, vres_mu, w_br_a, w_br_b, w_br_c, w_out,
              w_ff1, w_ff2, final_g):
    v_first = None
    v_first_c = None
    for i in range(DEPTH):
        last = i == DEPTH - 1
        lp = {
            'w_in': w_in[i], 'rpb': rpb[i], 'conv_w': conv_w[i], 'conv_b': conv_b[i],
            'rg_wa': rg_wa[i], 'rg_ba': rg_ba[i], 'rg_wx': rg_wx[i], 'rg_bx': rg_bx[i], 'rg_lam': rg_lam[i],
            'rw_mu_rkv': rw_mu_rkv[i], 'rw_mu_h': rw_mu_h[i], 'rw_w0': rw_w0[i], 'rw_w1': rw_w1[i],
            'rw_w2': rw_w2[i], 'rw_a0': rw_a0[i], 'rw_a1': rw_a1[i], 'rw_a2': rw_a2[i],
            'rw_g1': rw_g1[i], 'rw_g2': rw_g2[i], 'rw_k_k': rw_k_k[i], 'rw_k_a': rw_k_a[i],
            'rw_r_k': rw_r_k[i], 'rw_ln_w': rw_ln_w[i], 'rw_ln_b': rw_ln_b[i],
            'w_br_a': w_br_a[i], 'w_br_b': w_br_b[i], 'w_br_c': w_br_c[i], 'w_out': w_out[i],
        }
        vres = None if i == 0 else (vres_v0[i - 1], vres_v1[i - 1], vres_v2[i - 1], vres_mu[i - 1])
        sh1, sc1, gt1, sh2, sc2, gt2 = jnp.split((jax.nn.silu(c) @ w_ada[i] + b_ada[i])[:, None, :], 6, axis=-1)
        csh1, csc1, cgt1, csh2, csc2, cgt2 = jnp.split(jax.nn.silu(c_ctx) @ w_ada[i] + b_ada[i], 6, axis=-1)
        h = _rmsnorm(x, norm1_g[i]) * (1.0 + sc1) + sh1
        hc = _rmsnorm(ctx, norm1_g[i]) * (1.0 + csc1) + csh1
        y, y_c, v_first, v_first_c = _hybrid_mixer(h, hc, lp, vres, v_first, v_first_c, not last)
        x = x + gt1 * y
        x = x + gt2 * _sqrelu_mlp(_rmsnorm(x, norm2_g[i]) * (1.0 + sc2) + sh2, w_ff1[i], w_ff2[i])
        if not last:
            ctx = ctx + cgt1 * y_c
            ctx = ctx + cgt2 * _sqrelu_mlp(_rmsnorm(ctx, norm2_g[i]) * (1.0 + csc2) + csh2, w_ff1[i], w_ff2[i])
    return _rmsnorm(x, final_g)
```

```cpp
#include <hip/hip_runtime.h>
#include <hip/hip_cooperative_groups.h>
#include <cstdio>
#include <cstdint>
namespace cg = cooperative_groups;

#define GAS __attribute__((address_space(1)))
#define LAS __attribute__((address_space(3)))
typedef unsigned short bf16;
typedef _Float16 f16;
typedef float f32x4 __attribute__((ext_vector_type(4)));
typedef float f32x2 __attribute__((ext_vector_type(2)));
typedef short bf16x8 __attribute__((ext_vector_type(8)));
typedef short s16x4 __attribute__((ext_vector_type(4)));
typedef _Float16 f16x4 __attribute__((ext_vector_type(4)));
typedef unsigned u32x2 __attribute__((ext_vector_type(2)));
typedef unsigned u32x4 __attribute__((ext_vector_type(4)));
#define LDS_WAIT() asm volatile("s_waitcnt lgkmcnt(0)" ::: "memory")

constexpr int DM = 1024, SEQ = 8192, CTXL = 256, ML = 16384, MC = 512, M = ML + MC, NIN = 11264, NEXT = 12288, DFF = 4096;
constexpr int NWAVES = 8, NTHR = 512;
constexpr size_t SLOT = (size_t)M * 1024 * 2;
constexpr size_t WS_WIN = 9 * SLOT;
constexpr size_t WS_WBR = WS_WIN + (size_t)NEXT * 1024 * 2;
constexpr size_t WS_WOUT = WS_WBR + 3ull * 1024 * 1024 * 2;
constexpr size_t WS_WRG = WS_WOUT + 1024ull * 1024 * 2;
constexpr size_t WS_WLR2 = WS_WRG + 4096ull * 64 * 2;
constexpr size_t WS_A2 = WS_WLR2 + (4ull * 1024 * 64 + 1024 * 160 + 1024 * 32) * 2;
constexpr size_t WS_XCTX = WS_A2 + (size_t)M * 448 * 2;
constexpr size_t WS_MOD = WS_XCTX + 512ull * 1024 * 4;
constexpr size_t WS_ROPE = WS_MOD + 2ull * 3 * 6144 * 4;
constexpr size_t WS_BSUM = WS_ROPE + 128ull * 16 * 2 * 4;
constexpr size_t WS_RN = WS_BSUM + (size_t)M * 16 * 4;
constexpr size_t WS_SP8 = WS_RN + (size_t)M * 16 * 4;
constexpr size_t WS_BAR = WS_SP8 + 2048 * 4;
constexpr size_t WS_BSB = WS_BAR + 16384;
constexpr size_t WS_END = WS_BSB + (size_t)M * 16 * 4;
constexpr size_t LR2_ZF = 0, LR2_ZB = 1024 * 64, LR2_AF = 2 * 1024 * 64, LR2_AB = 3 * 1024 * 64, LR2_G = 4 * 1024 * 64, LR2_V = 4 * 1024 * 64 + 1024 * 160;
constexpr int LDS_BYTES = 131072 + 4096;

__device__ __forceinline__ unsigned f2bf(float f) { unsigned r; asm("v_cvt_pk_bf16_f32 %0, %1, %1" : "=v"(r) : "v"(f)); return r & 0xffffu; }
__device__ __forceinline__ unsigned pk2(float lo, float hi) { unsigned r; asm("v_cvt_pk_bf16_f32 %0, %1, %2" : "=v"(r) : "v"(lo), "v"(hi)); return r; }
__device__ __forceinline__ float bf2f(unsigned b) { return __builtin_bit_cast(float, b << 16); }
__device__ __forceinline__ void st_bf4(bf16* p, f32x4 v) { u32x2 w; w.x = pk2(v[0], v[1]); w.y = pk2(v[2], v[3]); *(u32x2*)p = w; }
__device__ __forceinline__ f32x4 ld_bf4(const bf16* p) { u32x2 w = *(const u32x2*)p; f32x4 v; v[0] = bf2f(w.x & 0xffffu); v[1] = bf2f(w.x >> 16); v[2] = bf2f(w.y & 0xffffu); v[3] = bf2f(w.y >> 16); return v; }
__device__ __forceinline__ void st_h4(f16* p, f32x4 v) { f16x4 h; h[0] = (f16)v[0]; h[1] = (f16)v[1]; h[2] = (f16)v[2]; h[3] = (f16)v[3]; *(f16x4*)p = h; }
__device__ __forceinline__ f32x4 ld_h4(const f16* p) { f16x4 h = *(const f16x4*)p; f32x4 v; v[0] = (float)h[0]; v[1] = (float)h[1]; v[2] = (float)h[2]; v[3] = (float)h[3]; return v; }
__device__ __forceinline__ float sigmoidf_(float x) { return __builtin_amdgcn_rcpf(1.f + __expf(-x)); }
template <int CTRL> __device__ __forceinline__ float dppf(float x) { return __builtin_bit_cast(float, __builtin_amdgcn_update_dpp(0, __builtin_bit_cast(int, x), CTRL, 0xf, 0xf, true)); }
__device__ __forceinline__ float quadsum(float x) { x += dppf<0xB1>(x); x += dppf<0x4E>(x); return x; }
__device__ __forceinline__ float allred16(float x) { x += dppf<0xB1>(x); x += dppf<0x4E>(x); x += dppf<0x141>(x); x += dppf<0x140>(x); return x; }
__device__ __forceinline__ float shx(float v, int mask, int lane) { return __builtin_bit_cast(float, __builtin_amdgcn_ds_bpermute((lane ^ mask) << 2, __builtin_bit_cast(int, v))); }
__device__ __forceinline__ void swap16(float x, float& a, float& b) { a = x; b = x; asm volatile("s_nop 1\n\tv_permlane16_swap_b32 %0, %1\n\ts_nop 1" : "+v"(a), "+v"(b)); }
__device__ __forceinline__ void swap32(float x, float& a, float& b) { a = x; b = x; asm volatile("s_nop 1\n\tv_permlane32_swap_b32 %0, %1\n\ts_nop 1" : "+v"(a), "+v"(b)); }
__device__ __forceinline__ float sum_fq(float x) { float a, b; swap16(x, a, b); x = a + b; swap32(x, a, b); return a + b; }
__device__ __forceinline__ float max_fq(float x) { float a, b; swap16(x, a, b); x = fmaxf(a, b); swap32(x, a, b); return fmaxf(a, b); }
__device__ __forceinline__ float wave_sum(float v, int lane) {
    v = allred16(v); return sum_fq(v);
}
__device__ __forceinline__ void seq_of(int m, int& s0, int& len, int& pos) {
    if (m < ML) { s0 = m & ~(SEQ - 1); len = SEQ; pos = m & (SEQ - 1); }
    else { s0 = ML + ((m - ML) & ~(CTXL - 1)); len = CTXL; pos = (m - ML) & (CTXL - 1); }
}
namespace pg8 {
#define PG8_LAS __attribute__((address_space(3)))
typedef unsigned short bf16_t;
typedef short bf16x8 __attribute__((ext_vector_type(8)));
typedef float f32x4 __attribute__((ext_vector_type(4)));
typedef unsigned u32x4 __attribute__((ext_vector_type(4)));
constexpr int BM = 256, BK = 64, HALF = 128, HTB = HALF * BK * 2  , STAGE_BYTES = 8 * HTB, NXCD = 8, WGM = 8;

__host__ __device__ __forceinline__ int lds_byte(int r, int c) { const int st = (r >> 4) * 2 + (c >> 5), rr = r & 15, cc = c & 31, ob = rr * 64 + cc * 2; return st * 1024 + (ob ^ (((ob >> 9) & 1) << 5)); }
__host__ __device__ __forceinline__ void stage_rc(int b, int& R, int& C) { const int st = b / 1024, sb = b % 1024, swz = sb ^ (((sb >> 9) & 1) << 5); R = (st >> 1) * 16 + swz / 64; C = (st & 1) * 32 + (swz % 64) / 2; }
__host__ __device__ __forceinline__ int perm32(int rho) { const int n = rho >> 4, i = rho & 15; return 8 * (i >> 2) + 4 * n + (i & 3); }

struct Unit { int pm, pn; };
struct Gemm { const bf16_t* A; const bf16_t* Bt; int M, N, K; };

struct StaticOrder {
    int nM, nN, nwg, G, c;
    __host__ __device__ void init(int M, int N, int G_, int c_) { nM = M / BM; nN = N / BM; nwg = nM * nN; G = G_; c = c_; }
    __host__ __device__ bool next(int i, Unit& u) const {
        const long L = (long)i * G + c; if (L >= nwg) return false;
        int wgid = (int)L; { const int q = nwg / NXCD, r = nwg % NXCD, xcd = wgid % NXCD, off = wgid / NXCD; wgid = (xcd < r ? xcd * (q + 1) : r * (q + 1) + (xcd - r) * q) + off; }
        const int nig = WGM * nN, gid = wgid / nig, fm = gid * WGM, gsz = (nM - fm) < WGM ? (nM - fm) : WGM;
        u.pm = fm + ((wgid % nig) % gsz); u.pn = (wgid % nig) / gsz; return true;
    }
    __device__ __forceinline__ void a_ready(const Unit&) const {}
    __device__ __forceinline__ void done(const Unit&) const {}
};
template <class Epi, class Sched, bool ALIGN_EPI = false, bool SP2 = false>
__device__ __forceinline__ void gemm_phase(PG8_LAS unsigned char* lds, const Gemm g, const Sched& S, const Epi& E) {
    int tid_ = threadIdx.x; asm volatile("" : "+v"(tid_)); const int tid = tid_, wid = __builtin_amdgcn_readfirstlane(tid >> 6), lane = tid & 63, wr = wid >> 2, wc = wid & 3, fr = lane & 15, fq = lane >> 4;
    const int K = g.K, nt = K / BK;
    unsigned voffA[2], voffB[2];
#pragma unroll
    for (int i = 0; i < 2; ++i) { int R, C; stage_rc(tid * 16 + i * 8192, R, C); const int Rb = Epi::PERM ? ((R & ~31) + perm32(R & 31)) : R;
        voffA[i] = (unsigned)(R * K + C) * 2u; voffB[i] = (unsigned)(Rb * K + C) * 2u; }
    const size_t kstep = (size_t)(BK * 2);
    const size_t hstep = (size_t)HALF * K * 2;
    const size_t tstep = 2 * hstep;
    const unsigned ldsw = (unsigned)wid * 1024u;
    const int aoff = lds_byte(wr * 64 + fr, fq * 8), boff = lds_byte(wc * 32 + fr, fq * 8);
#define PG8_SA(b, h) (((b) * 2 + (h)) * HTB)
#define PG8_SB(b, h) ((4 + (b) * 2 + (h)) * HTB)
#define PG8_STAGE(bufoff, gbase, voff) do { _Pragma("unroll") for (int _i = 0; _i < 2; ++_i) \
        __builtin_amdgcn_global_load_lds((const unsigned*)((const char*)(gbase) + (voff)[_i]), (PG8_LAS unsigned*)(lds + (bufoff) + ldsw + _i * 8192), 16, 0, 0); } while (0)
#define PG8_LDA(dst, b, h) do { _Pragma("unroll") for (int m = 0; m < 4; ++m) _Pragma("unroll") for (int k = 0; k < 2; ++k) dst[m][k] = *(const PG8_LAS bf16x8*)(lds + PG8_SA(b, h) + aoff + m * 2048 + k * 1024); } while (0)
#define PG8_LDB(dst, b, h) do { _Pragma("unroll") for (int n = 0; n < 2; ++n) _Pragma("unroll") for (int k = 0; k < 2; ++k) dst[n][k] = *(const PG8_LAS bf16x8*)(lds + PG8_SB(b, h) + boff + n * 2048 + k * 1024); } while (0)
#define PG8_MMA(ai, bj, At, Bt) do { __builtin_amdgcn_s_setprio(1); _Pragma("unroll") for (int m = 0; m < 4; ++m) _Pragma("unroll") for (int n = 0; n < 2; ++n) _Pragma("unroll") for (int k = 0; k < 2; ++k) \
        acc[ai][bj][m][n] = __builtin_amdgcn_mfma_f32_16x16x32_bf16(Bt[n][k], At[m][k], acc[ai][bj][m][n], 0, 0, 0); __builtin_amdgcn_s_setprio(0); } while (0)
#define PG8_WAIT_V(n) asm volatile("s_waitcnt vmcnt(" #n ")" ::: "memory")
#define PG8_WAIT_L(n) asm volatile("s_waitcnt lgkmcnt(" #n ")" ::: "memory")
#define PG8_BAR __builtin_amdgcn_s_barrier()
#define PG8_SCHED __builtin_amdgcn_sched_barrier(0)
    Unit cur, nxt; int ui = 0;
    if (!S.next(0, cur)) return;
    f32x4 acc[2][2][4][2];
#pragma unroll
    for (int a = 0; a < 2; ++a)
#pragma unroll
        for (int b = 0; b < 2; ++b)
#pragma unroll
            for (int m = 0; m < 4; ++m)
#pragma unroll
                for (int n = 0; n < 2; ++n) acc[a][b][m][n] = (f32x4){0.f, 0.f, 0.f, 0.f};
    bf16x8 At[4][2], B0[2][2], B1[2][2];
    const char* cA = (const char*)g.A + (size_t)cur.pm * tstep; const char* cB = (const char*)g.Bt + (size_t)cur.pn * tstep;
    S.a_ready(cur);
    if constexpr (SP2) {
        PG8_STAGE(PG8_SB(0, 0), cB, voffB); PG8_STAGE(PG8_SB(0, 1), cB + hstep, voffB); PG8_STAGE(PG8_SA(0, 0), cA, voffA); PG8_STAGE(PG8_SA(0, 1), cA + hstep, voffA);
        if (wr == 1) PG8_BAR;
        PG8_WAIT_V(2); PG8_BAR;
        PG8_STAGE(PG8_SB(1, 0), cB + kstep, voffB); PG8_STAGE(PG8_SA(1, 0), cA + kstep, voffA); PG8_STAGE(PG8_SB(1, 1), cB + hstep + kstep, voffB);
        PG8_WAIT_V(6); PG8_BAR;
    } else {
        PG8_STAGE(PG8_SB(0, 0), cB, voffB); PG8_STAGE(PG8_SA(0, 0), cA, voffA); PG8_STAGE(PG8_SB(0, 1), cB + hstep, voffB); PG8_STAGE(PG8_SA(0, 1), cA + hstep, voffA);
        if (wr == 1) PG8_BAR;
        PG8_WAIT_V(4); PG8_BAR;
        PG8_STAGE(PG8_SB(1, 0), cB + kstep, voffB); PG8_STAGE(PG8_SA(1, 0), cA + kstep, voffA); PG8_STAGE(PG8_SB(1, 1), cB + hstep + kstep, voffB);
        PG8_WAIT_V(6); PG8_BAR;
    }
    for (;;) {
        const bool has_next = S.next(ui + 1, nxt);
        const char* nA = has_next ? (const char*)g.A + (size_t)nxt.pm * tstep : cA; const char* nB = has_next ? (const char*)g.Bt + (size_t)nxt.pn * tstep : cB;
        for (int t = 0; t < nt; t += 2) {
            const bool last = (t == nt - 2);
            const char* a1 = cA + (size_t)(t + 1) * kstep;
            const char* a2 = last ? nA : cA + (size_t)(t + 2) * kstep; const char* b2 = last ? nB : cB + (size_t)(t + 2) * kstep;
            const char* a3 = a2 + kstep; const char* b3 = b2 + kstep;
            if (last && has_next) S.a_ready(nxt);
            if constexpr (SP2) {
            PG8_LDB(B0, 0, 0); PG8_LDB(B1, 0, 1); PG8_SCHED; PG8_LDA(At, 0, 0); PG8_STAGE(PG8_SA(1, 1), a1 + hstep, voffA);
            PG8_WAIT_V(8); PG8_WAIT_L(0); PG8_BAR; PG8_MMA(0, 0, At, B0); PG8_MMA(0, 1, At, B1); PG8_BAR; PG8_SCHED;
            PG8_LDA(At, 0, 1); PG8_STAGE(PG8_SB(0, 0), b2, voffB); PG8_STAGE(PG8_SB(0, 1), b2 + hstep, voffB); PG8_STAGE(PG8_SA(0, 0), a2, voffA);
            PG8_WAIT_V(8); PG8_WAIT_L(0); PG8_BAR; PG8_MMA(1, 0, At, B0); PG8_MMA(1, 1, At, B1); PG8_BAR; PG8_SCHED;
            PG8_LDB(B0, 1, 0); PG8_LDB(B1, 1, 1); PG8_SCHED; PG8_LDA(At, 1, 0); PG8_STAGE(PG8_SA(0, 1), a2 + hstep, voffA);
            PG8_WAIT_V(8); PG8_WAIT_L(0); PG8_BAR; PG8_MMA(0, 0, At, B0); PG8_MMA(0, 1, At, B1); PG8_BAR; PG8_SCHED;
            PG8_LDA(At, 1, 1); PG8_STAGE(PG8_SB(1, 0), b3, voffB); PG8_STAGE(PG8_SB(1, 1), b3 + hstep, voffB); PG8_STAGE(PG8_SA(1, 0), a3, voffA);
            PG8_WAIT_V(8); PG8_WAIT_L(0); PG8_BAR; PG8_MMA(1, 0, At, B0); PG8_MMA(1, 1, At, B1); PG8_BAR; PG8_SCHED;
            } else {
            PG8_LDB(B0, 0, 0); PG8_SCHED; PG8_LDA(At, 0, 0); PG8_STAGE(PG8_SA(1, 1), a1 + hstep, voffA);
            PG8_WAIT_L(8); PG8_BAR; PG8_WAIT_L(0); PG8_MMA(0, 0, At, B0); PG8_BAR; PG8_SCHED;
            PG8_LDB(B1, 0, 1); PG8_STAGE(PG8_SB(0, 0), b2, voffB);
            PG8_BAR; PG8_WAIT_L(0); PG8_MMA(0, 1, At, B1); PG8_BAR;
            PG8_LDA(At, 0, 1); PG8_STAGE(PG8_SA(0, 0), a2, voffA);
            PG8_BAR; PG8_WAIT_L(0); PG8_MMA(1, 0, At, B0); PG8_BAR; PG8_SCHED;
            PG8_STAGE(PG8_SB(0, 1), b2 + hstep, voffB);
            PG8_WAIT_V(6); PG8_BAR; PG8_MMA(1, 1, At, B1); PG8_BAR;
            PG8_LDB(B0, 1, 0); PG8_SCHED; PG8_LDA(At, 1, 0); PG8_STAGE(PG8_SA(0, 1), a2 + hstep, voffA);
            PG8_WAIT_L(8); PG8_BAR; PG8_WAIT_L(0); PG8_MMA(0, 0, At, B0); PG8_BAR; PG8_SCHED;
            PG8_LDB(B1, 1, 1); PG8_STAGE(PG8_SB(1, 0), b3, voffB);
            PG8_BAR; PG8_WAIT_L(0); PG8_MMA(0, 1, At, B1); PG8_BAR;
            PG8_LDA(At, 1, 1); PG8_STAGE(PG8_SA(1, 0), a3, voffA);
            PG8_BAR; PG8_WAIT_L(0); PG8_MMA(1, 0, At, B0); PG8_BAR; PG8_SCHED;
            PG8_STAGE(PG8_SB(1, 1), b3 + hstep, voffB);
            PG8_WAIT_V(6); PG8_BAR; PG8_MMA(1, 1, At, B1); PG8_BAR;
            }
        }
        if constexpr (ALIGN_EPI) { if (wr == 0) PG8_BAR; }
        if constexpr (!Epi::AFTER_DRAIN) { E(acc, cur, wr, wc, fr, fq); S.done(cur); }
        if (!has_next) break;
#pragma unroll
        for (int a = 0; a < 2; ++a)
#pragma unroll
            for (int b = 0; b < 2; ++b)
#pragma unroll
                for (int m = 0; m < 4; ++m)
#pragma unroll
                    for (int n = 0; n < 2; ++n) acc[a][b][m][n] = (f32x4){0.f, 0.f, 0.f, 0.f};
        cur = nxt; cA = nA; cB = nB; ++ui;
        if constexpr (ALIGN_EPI) { if (wr == 1) PG8_BAR; }
    }
    PG8_WAIT_V(0);
    if constexpr (!ALIGN_EPI) { if (wr == 0) PG8_BAR; }
    PG8_BAR;
    if constexpr (Epi::AFTER_DRAIN) { E.fused(acc, cur, wr, wc, fr, fq, lds, wid, lane); S.done(cur); }
#undef PG8_SA
#undef PG8_SB
#undef PG8_STAGE
#undef PG8_LDA
#undef PG8_LDB
#undef PG8_MMA
#undef PG8_WAIT_V
#undef PG8_WAIT_L
#undef PG8_BAR
#undef PG8_SCHED
}
}

#define FI __device__ __forceinline__
struct Params { const float* in[43]; float* out; unsigned char* ws; int ph_lo, ph_hi; };
struct TI { int tid, lane, wave, gw, NGW, gtid, NT, vb; LAS unsigned char* lds; };
FI const float* ldsptr(LAS unsigned char* lds, int i) { volatile LAS unsigned* p = (volatile LAS unsigned*)(lds + 131072) + 2 * i; const unsigned lo = __builtin_amdgcn_readfirstlane(p[0]), hi = __builtin_amdgcn_readfirstlane(p[1]); return (const float*)(GAS const float*)(((unsigned long long)hi << 32) | lo); }
FI TI mk_ti(LAS unsigned char* lds) { TI T; int tid = threadIdx.x; asm volatile("" : "+v"(tid)); int bx = blockIdx.x; asm volatile("" : "+s"(bx)); int gx = gridDim.x; asm volatile("" : "+s"(gx));
    const int vb = (gx & 7) == 0 ? (bx & 7) * (gx >> 3) + (bx >> 3) : bx; T.vb = vb;
    T.tid = tid; T.lane = tid & 63; T.wave = __builtin_amdgcn_readfirstlane(tid >> 6); T.gw = vb * NWAVES + T.wave; T.NGW = gx * NWAVES; T.gtid = vb * NTHR + tid; T.NT = gx * NTHR; unsigned lo_ = (unsigned)(unsigned long long)lds; asm volatile("" : "+s"(lo_)); T.lds = (LAS unsigned char*)(unsigned long long)lo_; return T; }
#define PIN(i) ldsptr(T.lds, (i))
#define POUT ((float*)ldsptr(T.lds, 43))
#define PWS ((unsigned char*)ldsptr(T.lds, 44))

FI bf16* slotb(unsigned char* ws, int i) { return (bf16*)(ws + (size_t)i * SLOT); }
FI f16* sloth(unsigned char* ws, int i) { return (f16*)(ws + (size_t)i * SLOT); }

FI void ph_mod(const TI& T) {
    const float* c = PIN(1); const float* cctx = PIN(3); const float* w_ada = PIN(4); const float* b_ada = PIN(5);
    float* MOD = (float*)(PWS + WS_MOD);
    LAS float* red = (LAS float*)T.lds;
    for (int task = T.vb; task < 192; task += gridDim.x) {
        const int l = task / 96, n = (task % 96) * 64 + T.lane;
        float a0 = 0.f, a1 = 0.f, a2 = 0.f;
        const float* wp = w_ada + ((size_t)l * 1024 + T.wave * 128) * 6144 + n;
#pragma unroll 16
        for (int kk = 0; kk < 128; ++kk) {
            const int k = T.wave * 128 + kk;
            const float wv = __builtin_nontemporal_load(wp + (size_t)kk * 6144);
            const float c0 = c[k], c1 = c[1024 + k], c2 = cctx[k];
            a0 += c0 * sigmoidf_(c0) * wv; a1 += c1 * sigmoidf_(c1) * wv; a2 += c2 * sigmoidf_(c2) * wv;
        }
        red[(T.wave * 3 + 0) * 64 + T.lane] = a0; red[(T.wave * 3 + 1) * 64 + T.lane] = a1; red[(T.wave * 3 + 2) * 64 + T.lane] = a2;
        __syncthreads();
        if (T.wave == 0) {
#pragma unroll
            for (int s = 0; s < 3; ++s) { float t = 0.f;
#pragma unroll
                for (int w = 0; w < 8; ++w) t += red[(w * 3 + s) * 64 + T.lane];
                MOD[((size_t)l * 3 + s) * 6144 + n] = t + b_ada[l * 6144 + n]; }
        }
        __syncthreads();
    }
    float* tab = (float*)(PWS + WS_ROPE);
    for (int i = T.gtid; i < 2048; i += T.NT) { const int pos = i >> 4, f = i & 15; const float invf = powf(10000.f, -(float)f / 16.f); const float ang = (float)pos * invf; tab[2 * i] = cosf(ang); tab[2 * i + 1] = sinf(ang); }
}

template <class SRC>
FI void transpose_item(const SRC& src, int K, bf16* WT, int k0, int n0, LAS float* scr, int lane) {
    float tv[32];
#pragma unroll
    for (int i = 0; i < 32; ++i) tv[i] = src(k0 + 2 * i + (lane >> 5), n0 + (lane & 31));
#pragma unroll
    for (int i = 0; i < 32; ++i) scr[(2 * i + (lane >> 5)) * 33 + (lane & 31)] = tv[i];
    LDS_WAIT(); asm volatile("" ::: "memory");
    const int c = lane & 7;
#pragma unroll
    for (int j = 0; j < 4; ++j) { const int n = (lane >> 3) + 8 * j; const LAS float* s = scr + (8 * c) * 33 + n;
        u32x4 o; o.x = pk2(s[0 * 33], s[1 * 33]); o.y = pk2(s[2 * 33], s[3 * 33]); o.z = pk2(s[4 * 33], s[5 * 33]); o.w = pk2(s[6 * 33], s[7 * 33]);
        *(u32x4*)(WT + (size_t)(n0 + n) * K + k0 + 8 * c) = o; }
    LDS_WAIT(); asm volatile("" ::: "memory");
}
struct SrcPlain { const float* W; int N; FI float operator()(int k, int n) const { return __builtin_nontemporal_load(W + (size_t)k * N + n); } };
struct SrcWin { const float *w_in, *w1, *a1, *g1, *v1, *mu_h, *mu_v; int layer;
    FI float operator()(int k, int n) const {
        if (n < 8192) return __builtin_nontemporal_load(w_in + (size_t)k * NIN + n);
        if (n >= 9216) return __builtin_nontemporal_load(w_in + (size_t)k * NIN + (n - 1024));
        const int j = n - 8192; if (j >= 896) return 0.f;
        const int part = j >= 448 ? 1 : 0; const int jj = part ? j - 448 : j;
        float w, mu;
        if (jj < 128) { const int d = jj >> 6, cc = jj & 63; w = w1[((size_t)d * 1024 + k) * 64 + cc]; mu = mu_h[k]; }
        else if (jj < 256) { const int d = (jj - 128) >> 6, cc = jj & 63; w = a1[((size_t)d * 1024 + k) * 64 + cc]; mu = mu_h[1024 + k]; }
        else if (jj < 416) { w = g1[(size_t)k * 160 + (jj - 256)]; mu = mu_h[2048 + k]; }
        else { if (layer == 0) return 0.f; w = v1[(size_t)k * 32 + (jj - 416)]; mu = mu_v[k]; }
        return part ? w * mu : w * (1.f - mu);
    } };

FI void ph_weights_mixer(const TI& T, int l) {
    LAS float* scr = (LAS float*)(T.lds + T.wave * 16384);
    SrcWin sw; sw.w_in = PIN(8) + (size_t)l * 1024 * NIN; sw.w1 = PIN(20) + (size_t)l * 2 * 1024 * 64; sw.a1 = PIN(23) + (size_t)l * 2 * 1024 * 64;
    sw.g1 = PIN(25) + (size_t)l * 1024 * 160; sw.v1 = PIN(33) + (size_t)(l > 0 ? l - 1 : 0) * 1024 * 32; sw.mu_h = PIN(18) + (size_t)l * 3 * 1024; sw.mu_v = PIN(35) + (size_t)(l > 0 ? l - 1 : 0) * 1024; sw.layer = l;
    bf16* WIN = (bf16*)(PWS + WS_WIN);
    constexpr int I_IN = 16 * 384, I_SQ = 16 * 32;
    for (int it = T.gw; it < I_IN + 4 * I_SQ; it += T.NGW) {
        int r = it;
        if (r < I_IN) { transpose_item(sw, 1024, WIN, (r / 384) * 64, (r % 384) * 32, scr, T.lane); continue; }
        r -= I_IN; const int which = r / I_SQ; r %= I_SQ;
        SrcPlain sp; sp.N = 1024; sp.W = PIN(36 + which) + (size_t)l * 1024 * 1024;
        bf16* WT = which < 3 ? (bf16*)(PWS + WS_WBR) + (size_t)which * 1024 * 1024 : (bf16*)(PWS + WS_WOUT);
        transpose_item(sp, 1024, WT, (r / 32) * 64, (r % 32) * 32, scr, T.lane);
    }
    bf16* WRG = (bf16*)(PWS + WS_WRG);
    for (int i = T.gtid; i < 4096 * 64; i += T.NT) { const int n = i >> 6, d = i & 63, dir = n >> 11, blk = (n >> 7) & 15, hb = (n >> 6) & 1, which = (n >> 5) & 1, e = hb * 32 + (n & 31);
        const float* W = (which ? PIN(14) : PIN(12)) + ((((size_t)l * 2 + dir) * 16 + blk) * 64 + d) * 64 + e; WRG[i] = (bf16)f2bf(*W); }
    for (int i = T.gtid; i < 2048; i += T.NT) ((float*)(PWS + WS_SP8))[i] = 8.f * log1pf(__expf(-PIN(16)[(size_t)l * 2048 + i]));
    bf16* L2 = (bf16*)(PWS + WS_WLR2);
    for (int i = T.gtid; i < 4 * 1024 * 64; i += T.NT) { const int g = i >> 16, n = (i >> 6) & 1023, k = i & 63; const int dir = g & 1;
        const float* W = (g < 2 ? PIN(21) : PIN(24)) + (((size_t)l * 2 + dir) * 64 + k) * 1024 + n; L2[i] = (bf16)f2bf(*W); }
    for (int i = T.gtid; i < 1024 * 160; i += T.NT) { const int n = i / 160, k = i % 160; L2[LR2_G + i] = (bf16)f2bf(PIN(26)[((size_t)l * 160 + k) * 1024 + n]); }
    if (l > 0) for (int i = T.gtid; i < 1024 * 32; i += T.NT) { const int n = i >> 5, k = i & 31; L2[LR2_V + i] = (bf16)f2bf(PIN(34)[((size_t)(l - 1) * 32 + k) * 1024 + n]); }
}
FI void ph_weights_mlp(const TI& T, int l) {
    LAS float* scr = (LAS float*)(T.lds + T.wave * 16384);
    bf16* W1T = (bf16*)(PWS + WS_WIN); bf16* W2T = W1T + (size_t)4096 * 1024;
    for (int it = T.gw; it < 4096; it += T.NGW) {
        if (it < 2048) { SrcPlain sp; sp.N = 4096; sp.W = PIN(40) + (size_t)l * 1024 * 4096; transpose_item(sp, 1024, W1T, (it / 128) * 64, (it % 128) * 32, scr, T.lane); }
        else { const int r = it - 2048; SrcPlain sp; sp.N = 1024; sp.W = PIN(41) + (size_t)l * 4096 * 1024; transpose_item(sp, 4096, W2T, (r / 32) * 64, (r % 32) * 32, scr, T.lane); }
    }
}

FI void ph_norm(const TI& T, int l, int which, bf16* __restrict__ H) {
    const float* __restrict__ gam = PIN(which ? 7 : 6) + l * 1024;
    const float* MODl = (const float*)(PWS + WS_MOD) + (size_t)l * 3 * 6144;
    const bool first = (l == 0 && which == 0);
#pragma unroll 2
    for (int m = T.gw; m < M; m += T.NGW) {
        const float* __restrict__ xr; int s;
        if (m < ML) { xr = (first ? PIN(0) : (const float*)POUT) + (size_t)m * 1024; s = m >> 13; }
        else { xr = (first ? PIN(2) : (const float*)(PWS + WS_XCTX)) + (size_t)(m - ML) * 1024; s = 2; }
        const float* sh = MODl + s * 6144 + (which ? 3072 : 0); const float* sc = sh + 1024;
        f32x4 v[4]; float ss = 0.f;
#pragma unroll
        for (int j = 0; j < 4; ++j) { v[j] = *(const f32x4*)(xr + (64 * j + T.lane) * 4); ss += (v[j][0] * v[j][0] + v[j][1] * v[j][1]) + (v[j][2] * v[j][2] + v[j][3] * v[j][3]); }
        const float rstd = rsqrtf(wave_sum(ss, T.lane) * (1.f / 1024.f) + 1e-6f);
#pragma unroll
        for (int j = 0; j < 4; ++j) { const int cc = (64 * j + T.lane) * 4; const f32x4 g4 = *(const f32x4*)(gam + cc), sc4 = *(const f32x4*)(sc + cc), sh4 = *(const f32x4*)(sh + cc);
            const f32x4 o = (v[j] * rstd * g4) * (1.f + sc4) + sh4; st_bf4(H + (size_t)m * 1024 + cc, o); }
    }
}
FI void ph_final(const TI& T) {
    const float* gam = PIN(42);
    for (int m = T.gw; m < ML; m += T.NGW) {
        float* xr = POUT + (size_t)m * 1024; f32x4 v[4]; float ss = 0.f;
#pragma unroll
        for (int j = 0; j < 4; ++j) { v[j] = *(const f32x4*)(xr + (64 * j + T.lane) * 4); ss += (v[j][0] * v[j][0] + v[j][1] * v[j][1]) + (v[j][2] * v[j][2] + v[j][3] * v[j][3]); }
        const float rstd = rsqrtf(wave_sum(ss, T.lane) * (1.f / 1024.f) + 1e-6f);
#pragma unroll
        for (int j = 0; j < 4; ++j) { const int cc = (64 * j + T.lane) * 4; *(f32x4*)(xr + cc) = v[j] * rstd * *(const f32x4*)(gam + cc); }
    }
}

template <class F> struct Epi {
    static constexpr bool PERM = false, AFTER_DRAIN = false;
    F f;
    FI void operator()(const pg8::f32x4 (&acc)[2][2][4][2], const pg8::Unit& u, int wr, int wc, int fr, int fq) const {
#pragma unroll
        for (int ai = 0; ai < 2; ++ai)
#pragma unroll
            for (int m = 0; m < 4; ++m) { const int row = u.pm * 256 + ai * 128 + wr * 64 + m * 16 + fr;
#pragma unroll
                for (int bj = 0; bj < 2; ++bj) { const int col = u.pn * 256 + bj * 128 + wc * 32 + 4 * fq; f(row, col, acc[ai][bj][m][0], acc[ai][bj][m][1]); }
                asm volatile("" ::: "memory"); }
    }
};
template <class F> FI void run_gemm(const TI& T, const bf16* A, const bf16* Bt, int N, int K, const F& f) {
    pg8::Gemm g{A, Bt, M, N, K}; pg8::StaticOrder S; S.init(M, N, (int)gridDim.x, (int)blockIdx.x);
    Epi<F> E{f};
    pg8::gemm_phase<Epi<F>, pg8::StaticOrder, true, true>((PG8_LAS unsigned char*)T.lds, g, S, E);
}
struct FRw { unsigned char* ws;
    FI void operator()(int row, int col, f32x4 v0, f32x4 v1) const {
        f16* dst = sloth(ws, 1 + (col >> 10)) + (size_t)row * 1024 + (col & 1023); st_h4(dst, v0); st_h4(dst + 16, v1); } };
struct FNat { unsigned char* ws; const float* rope;
    FI void operator()(int row, int col, f32x4 v0, f32x4 v1) const {
        const int sel = col >> 10, cc = col & 1023;
        if (sel < 2) {
            if (row < ML) {
                const int t = row & (SEQ - 1); const int pos = ((cc >> 5) & 1) ? (t & 63) : (t >> 6);
                const float* tp = rope + ((size_t)pos * 16 + (cc & 15)) * 2;
                const f32x4 t0 = *(const f32x4*)tp, t1 = *(const f32x4*)(tp + 4);
                const f32x4 cs = {t0[0], t0[2], t1[0], t1[2]}, sn = {t0[1], t0[3], t1[1], t1[3]};
                const f32x4 o0 = v0 * cs - v1 * sn, o1 = v0 * sn + v1 * cs; v0 = o0; v1 = o1;
            }
            bf16* dst = slotb(ws, 1 + sel) + (size_t)row * 1024 + cc; st_bf4(dst, v0); st_bf4(dst + 16, v1);
        } else {
            const int h = (cc >> 6), d = cc & 63; bf16* vt = slotb(ws, 3); size_t base, stride;
            if (row < ML) { const int b = row >> 13, t = row & (SEQ - 1); stride = SEQ; base = ((size_t)(b * 16 + h) * 64 + d) * SEQ + t; }
            else { const int rr = row - ML, b = rr >> 8, j = rr & 255; stride = CTXL; base = (size_t)ML * 1024 + ((size_t)(b * 16 + h) * 64 + d) * CTXL + j; }
#pragma unroll
            for (int i = 0; i < 4; ++i) { vt[base + i * stride] = (bf16)f2bf(v0[i]); vt[base + (16 + i) * stride] = (bf16)f2bf(v1[i]); }
        }
    } };
FI f32x4 gelu4(f32x4 x) { f32x4 o;
#pragma unroll
    for (int i = 0; i < 4; ++i) { const float u = 0.7978845608f * (x[i] + 0.044715f * x[i] * x[i] * x[i]); o[i] = x[i] * sigmoidf_(2.f * u); } return o; }
FI f32x4 sig4(f32x4 x) { f32x4 o;
#pragma unroll
    for (int i = 0; i < 4; ++i) o[i] = sigmoidf_(x[i]); return o; }
struct FLru { unsigned char* ws;
    FI void operator()(int row, int col, f32x4 v0, f32x4 v1) const {
        const int sel = col >> 10, cc = col & 1023; bf16* dst = slotb(ws, 2 + sel) + (size_t)row * 1024 + cc;
        if (sel) { v0 = gelu4(v0); v1 = gelu4(v1); } st_bf4(dst, v0); st_bf4(dst + 16, v1); } };
struct FGate { unsigned char* ws;
    FI void operator()(int row, int col, f32x4 v0, f32x4 v1) const {
        const int sel = col >> 10, cc = col & 1023; bf16* dst = slotb(ws, sel == 0 ? 2 : (sel == 1 ? 3 : 6)) + (size_t)row * 1024 + cc;
        st_bf4(dst, sig4(v0)); st_bf4(dst + 16, sig4(v1)); } };
template <int KB> struct FBr { const bf16* gate; bf16* mixed;
    FI void operator()(int row, int col, f32x4 v0, f32x4 v1) const {
        const size_t o = (size_t)row * 1024 + col; f32x4 r0 = ld_bf4(gate + o) * v0, r1 = ld_bf4(gate + o + 16) * v1;
        if (KB > 0) { r0 += ld_bf4(mixed + o); r1 += ld_bf4(mixed + o + 16); }
        st_bf4(mixed + o, r0); st_bf4(mixed + o + 16, r1); } };
struct FRes { const float* xl_old; float* xl_new; const float* xc_old; float* xc_new; const float* gt; bool ctx_store;
    FI void operator()(int row, int col, f32x4 v0, f32x4 v1) const {
        const float* xo; float* xn; const float* g;
        if (row < ML) { const size_t o = (size_t)row * 1024 + col; xo = xl_old + o; xn = xl_new + o; g = gt + (row >> 13) * 6144 + col; }
        else { if (!ctx_store) return; const size_t o = (size_t)(row - ML) * 1024 + col; xo = xc_old + o; xn = xc_new + o; g = gt + 2 * 6144 + col; }
        *(f32x4*)xn = *(const f32x4*)xo + *(const f32x4*)g * v0; *(f32x4*)(xn + 16) = *(const f32x4*)(xo + 16) + *(const f32x4*)(g + 16) * v1; } };
struct FFf1 { bf16* hid;
    FI void operator()(int row, int col, f32x4 v0, f32x4 v1) const {
        bf16* dst = hid + (size_t)row * 4096 + col;
#pragma unroll
        for (int i = 0; i < 4; ++i) { const float a = fmaxf(v0[i], 0.f), b = fmaxf(v1[i], 0.f); v0[i] = a * a; v1[i] = b * b; }
        st_bf4(dst, v0); st_bf4(dst + 16, v1); } };

template <int K, int MT, class F>
FI void sgemm_t(const TI& T, const bf16* __restrict__ A, int lda, int acol0, int blkmod, const bf16* __restrict__ Bt, int ncoltiles, const F& f, int blkshift = 0) {
    const int fr = T.lane & 15, fq = T.lane >> 4;
    const int nitems = (M / (16 * MT)) * ncoltiles;
    constexpr int KS = K / 32; constexpr bool PF = (K <= 64);
    bf16x8 af[PF ? KS : 1][MT], bfr[PF ? KS : 1][4];
#define SG_LOAD(it_, ks_, slot_) { const int rt_ = (it_) / ncoltiles, ct_ = (it_) % ncoltiles; const int acol_ = acol0 + (blkmod ? ((ct_ >> blkshift) % blkmod) * 64 : 0); \
        _Pragma("unroll") for (int m = 0; m < MT; ++m) af[slot_][m] = *(const bf16x8*)(A + (size_t)(rt_ * (16 * MT) + 16 * m + fr) * lda + acol_ + (ks_) * 32 + fq * 8); \
        _Pragma("unroll") for (int n = 0; n < 4; ++n) bfr[slot_][n] = *(const bf16x8*)(Bt + (size_t)(ct_ * 64 + 16 * n + fr) * K + (ks_) * 32 + fq * 8); }
    if (PF && T.gw < nitems) {
#pragma unroll
        for (int ks = 0; ks < KS; ++ks) SG_LOAD(T.gw, ks, (PF ? ks : 0));
    }
    for (int it = T.gw; it < nitems; it += T.NGW) {
        const int rt = it / ncoltiles, ct = it % ncoltiles, row0 = rt * (16 * MT);
        f32x4 acc[MT][4];
#pragma unroll
        for (int m = 0; m < MT; ++m)
#pragma unroll
            for (int n = 0; n < 4; ++n) acc[m][n] = (f32x4){0.f, 0.f, 0.f, 0.f};
#pragma unroll
        for (int ks = 0; ks < KS; ++ks) {
            if (!PF) SG_LOAD(it, ks, 0);
#pragma unroll
            for (int m = 0; m < MT; ++m)
#pragma unroll
                for (int n = 0; n < 4; ++n) acc[m][n] = __builtin_amdgcn_mfma_f32_16x16x32_bf16(bfr[PF ? ks : 0][n], af[PF ? ks : 0][m], acc[m][n], 0, 0, 0);
        }
        if (PF && it + T.NGW < nitems) {
#pragma unroll
            for (int ks = 0; ks < KS; ++ks) SG_LOAD(it + T.NGW, ks, (PF ? ks : 0));
        }
#pragma unroll
        for (int m = 0; m < MT; ++m) f.row(row0 + 16 * m + fr, ct, fq, acc[m]);
        f.tile_done(rt, ct);
    }
#undef SG_LOAD
}
template <int K, class F>
FI void sgemm(const TI& T, const bf16* __restrict__ A, int lda, int acol0, int blkmod, const bf16* __restrict__ Bt, int ncoltiles, const F& f, int blkshift = 0) { sgemm_t<K, 4, F>(T, A, lda, acol0, blkmod, Bt, ncoltiles, f, blkshift); }
#define ROWWISE FI void tile_done(int, int) const {} FI void row(int r, int ct, int fq, const f32x4 (&a)[4]) const { _Pragma("unroll") for (int n = 0; n < 4; ++n) (*this)(r, ct * 64 + 16 * n + 4 * fq, a[n]); }
struct FOmw { f16* dst; const float* bias;
    ROWWISE
    FI void operator()(int row, int col, f32x4 v) const { f32x4 o;
#pragma unroll
        for (int i = 0; i < 4; ++i) { const float sg = sigmoidf_(v[i] + bias[col + i]); o[i] = 1.f - __expf(-0.60653066f * sg); }
        st_h4(dst + (size_t)row * 1024 + col, o); } };
struct FSigH { f16* dst; const float* bias;
    ROWWISE
    FI void operator()(int row, int col, f32x4 v) const { f32x4 o;
#pragma unroll
        for (int i = 0; i < 4; ++i) o[i] = sigmoidf_(v[i] + bias[col + i]);
        st_h4(dst + (size_t)row * 1024 + col, o); } };
struct FLr2All { FI void tile_done(int, int) const {} unsigned char* ws; const float* w0; const float* a0;
    FI void row(int r, int ct, int fq, const f32x4 (&a)[4]) const {
        const int which = ct >> 4, ctl = ct & 15; const bool dec = which < 2;
        f16* dst = sloth(ws, which == 0 ? 1 : (which == 1 ? 3 : (which == 2 ? 2 : 4))) + (size_t)r * 1024;
        const float* bias = (dec ? w0 : a0) + (which & 1) * 1024;
#pragma unroll
        for (int n = 0; n < 4; ++n) { const int col = ctl * 64 + 16 * n + 4 * fq; f32x4 o;
#pragma unroll
            for (int i = 0; i < 4; ++i) { const float sg = sigmoidf_(a[n][i] + bias[col + i]); o[i] = dec ? 1.f - __expf(-0.60653066f * sg) : sg; }
            st_h4(dst + col, o); }
    } };
struct FVmix { f16* V; const f16* VF; const float* bias;
    ROWWISE
    FI void operator()(int row, int col, f32x4 a) const { const size_t o = (size_t)row * 1024 + col; f32x4 g;
#pragma unroll
        for (int i = 0; i < 4; ++i) g[i] = sigmoidf_(a[i] + bias[col + i]);
        const f32x4 v = ld_h4(V + o), vf = ld_h4(VF + o); st_h4(V + o, v + (vf - v) * g); } };
struct FPlainB { bf16* dst;
    ROWWISE
    FI void operator()(int row, int col, f32x4 v) const { st_bf4(dst + (size_t)row * 1024 + col, v); } };
struct FPost { FI void tile_done(int, int) const {} const bf16* __restrict__ YF; const bf16* __restrict__ YB; const f16* __restrict__ V; bf16* __restrict__ OUT; const float* __restrict__ BS; const float* __restrict__ BS2; const float* __restrict__ lnw; const float* __restrict__ lnb; int lane;
    FI void row(int r, int ct, int fq, const f32x4 (&g)[4]) const {
        const size_t o = (size_t)r * 1024 + ct * 64 + 4 * fq; f32x4 y[4], v[4]; float s = 0.f;
#pragma unroll
        for (int n = 0; n < 4; ++n) { y[n] = ld_bf4(YF + o + 16 * n) + ld_bf4(YB + o + 16 * n); v[n] = ld_h4(V + o + 16 * n); s += (y[n][0] + y[n][1]) + (y[n][2] + y[n][3]); }
        const float bsm = BS[(size_t)r * 16 + ct] + BS2[(size_t)r * 16 + ct];
        s = sum_fq(s);
        const float mean = s * (1.f / 64.f); float vs = 0.f;
#pragma unroll
        for (int n = 0; n < 4; ++n) { y[n] -= mean; vs += (y[n][0] * y[n][0] + y[n][1] * y[n][1]) + (y[n][2] * y[n][2] + y[n][3] * y[n][3]); }
        vs = sum_fq(vs);
        const float rstd = rsqrtf(vs * (1.f / 64.f) + 64e-5f);
#pragma unroll
        for (int n = 0; n < 4; ++n) { const int cc = ct * 64 + 16 * n + 4 * fq;
            const f32x4 yn = y[n] * rstd * *(const f32x4*)(lnw + cc) + *(const f32x4*)(lnb + cc);
            st_bf4(OUT + o + 16 * n, (yn + bsm * v[n]) * g[n]); }
    } };
struct FRgAB { unsigned char* ws; const float* ba; const float* bx; const float* sp8t; const bf16* UC; int bbslot; LAS f32x2* wl; int lane;
    FI void row(int r, int ct, int fq, const f32x4 (&acc)[4]) const {
        const int dir = ct >> 5, blk = (ct >> 1) & 15, hb = ct & 1;
        f16* OM = sloth(ws, dir ? 2 : 6); f16* BB = sloth(ws, dir ? bbslot : 7);
#pragma unroll
        for (int np = 0; np < 2; ++np) {
            const int ch = blk * 64 + hb * 32 + 16 * np + 4 * fq; const size_t o = (size_t)r * 1024 + ch;
            const f32x4 gr = acc[np] + *(const f32x4*)(ba + dir * 1024 + ch), gi = acc[np + 2] + *(const f32x4*)(bx + dir * 1024 + ch), sp = *(const f32x4*)(sp8t + dir * 1024 + ch), u = ld_bf4(UC + o);
            f32x4 om, bb;
#pragma unroll
            for (int i = 0; i < 4; ++i) { const float rr = sigmoidf_(gr[i]), ii = sigmoidf_(gi[i]), la = -sp[i] * rr; om[i] = 1.f - __expf(la); bb[i] = __builtin_amdgcn_sqrtf(fmaxf(1.f - __expf(2.f * la), 0.f)) * (ii * u[i]); }
            st_h4(OM + o, om); st_h4(BB + o, bb);
#pragma unroll
            for (int i = 0; i < 4; ++i) wl[(r & 63) * 32 + ((16 * np + 4 * fq + i) ^ (r & 15))] = (f32x2){1.f - (float)(f16)om[i], (float)(f16)bb[i]};
        }
    }
    FI void tile_done(int rt, int ct) const {
        LDS_WAIT();
        const int dir = ct >> 5, blk = (ct >> 1) & 15, hb = ct & 1;
        if (lane < 32) {
            float Ap = 1.f, Bp = 0.f;
#pragma unroll 16
            for (int i = 0; i < 64; ++i) { const int rr_ = dir ? 63 - i : i; const f32x2 ab = wl[rr_ * 32 + (lane ^ (rr_ & 15))]; Ap *= ab.x; Bp = ab.x * Bp + ab.y; }
            ((f32x2*)(ws + WS_A2))[((size_t)dir * 264 + rt) * 1024 + blk * 64 + hb * 32 + lane] = (f32x2){Ap, Bp};
        }
        LDS_WAIT();
    } };

FI void ph_shiftmix(const TI& T, int l, int vslot) {
    unsigned char* ws = PWS; const float* __restrict__ mu = PIN(17) + (size_t)l * 3 * 1024;
    bf16* __restrict__ A2 = (bf16*)(ws + WS_A2); const f16* __restrict__ LR = sloth(ws, 4);
    const f16* __restrict__ s0 = sloth(ws, 1); const f16* __restrict__ s1 = sloth(ws, 2); const f16* __restrict__ s2 = sloth(ws, 3);
    f16* __restrict__ d0 = sloth(ws, 5); f16* __restrict__ d1 = sloth(ws, 6); f16* __restrict__ d2 = sloth(ws, vslot);
    const float* __restrict__ kkp = PIN(27) + l * 1024; float* __restrict__ RN = (float*)(ws + WS_RN);
#pragma unroll 4
    for (int it = T.gtid; it < M * 256; it += T.NT) {
        const int m = it >> 8, cc = (it & 255) * 4; int sq0, len, pos; seq_of(m, sq0, len, pos);
        const bool hp = pos > 0, hn = pos < len - 1; const size_t o = (size_t)m * 1024 + cc;
        const size_t op = hp ? o - 1024 : o, on = hn ? o + 1024 : o; const float fp = hp ? 0.5f : 0.f, fn = hn ? 0.5f : 0.f;
        const f32x4 c0 = ld_h4(s0 + o), p0 = ld_h4(s0 + op), n0 = ld_h4(s0 + on), c1 = ld_h4(s1 + o), p1 = ld_h4(s1 + op), n1 = ld_h4(s1 + on), c2 = ld_h4(s2 + o), p2 = ld_h4(s2 + op), n2 = ld_h4(s2 + on);
        const f32x4 m0 = *(const f32x4*)(mu + cc), m1 = *(const f32x4*)(mu + 1024 + cc), m2 = *(const f32x4*)(mu + 2048 + cc);
        const f32x4 ks = c1 + m1 * ((fp * p1 + fn * n1) - c1);
        st_h4(d0 + o, c0 + m0 * ((fp * p0 + fn * n0) - c0)); st_h4(d1 + o, ks); st_h4(d2 + o, c2 + m2 * ((fp * p2 + fn * n2) - c2));
        const f32x4 kq = ks * *(const f32x4*)(kkp + cc); float ss = (kq[0] * kq[0] + kq[1] * kq[1]) + (kq[2] * kq[2] + kq[3] * kq[3]); ss = allred16(ss);
        if ((it & 15) == 0) RN[(size_t)m * 16 + (cc >> 6)] = 1.f / fmaxf(sqrtf(ss), 1e-12f);
    }
#pragma unroll 4
    for (int it = T.gtid; it < M * 112; it += T.NT) {
        const int m = it / 112, jc = (it % 112) * 4; int sq0, len, pos; seq_of(m, sq0, len, pos);
        const bool hp = pos > 0, hn = pos < len - 1; const size_t o = (size_t)m * 1024;
        const size_t op = hp ? o - 1024 : o, on = hn ? o + 1024 : o; const float fp = hp ? 0.5f : 0.f, fn = hn ? 0.5f : 0.f;
        f32x4 u = ld_h4(LR + o + jc); const f32x4 pv = ld_h4(LR + op + 448 + jc), nx = ld_h4(LR + on + 448 + jc);
        u += fp * pv + fn * nx;
        if (jc < 128) {
#pragma unroll
            for (int i = 0; i < 4; ++i) u[i] = 2.f * sigmoidf_(2.f * u[i]) - 1.f;
        } else if (jc >= 256 && jc < 416) u = sig4(u);
        st_bf4(A2 + (size_t)m * 448 + jc, u);
    }
}
FI void ph_rwprep(const TI& T, int l, int vslot) {
    unsigned char* ws = PWS;
    const float* __restrict__ k_k = PIN(27) + l * 1024; const float* __restrict__ k_a = PIN(28) + l * 1024; const float* __restrict__ r_k = PIN(29) + l * 1024;
    float* __restrict__ BS = (float*)(ws + WS_BSUM); float* __restrict__ RN = (float*)(ws + WS_RN);
    const f16* __restrict__ K = sloth(ws, 6); const f16* __restrict__ R = sloth(ws, 5); const f16* __restrict__ AF = sloth(ws, 2); const f16* __restrict__ AB = sloth(ws, 4);
    f16* __restrict__ V = sloth(ws, vslot); const f16* __restrict__ VF = sloth(ws, 8); const f16* __restrict__ VG = sloth(ws, 0);
    const int c0 = T.lane * 16, head = T.lane >> 2;
#pragma unroll 2
    for (int m = T.gw; m < M; m += T.NGW) {
        const size_t o = (size_t)m * 1024 + c0; float ss = 0.f, bs = 0.f;
#pragma unroll
        for (int q = 0; q < 4; ++q) {
            const int cc = c0 + 4 * q; const size_t oo = o + 4 * q;
            const f32x4 k = ld_h4(K + oo), r = ld_h4(R + oo), af = ld_h4(AF + oo), ab = ld_h4(AB + oo);
            const f32x4 kk4 = *(const f32x4*)(k_k + cc), ka4 = *(const f32x4*)(k_a + cc), rk4 = *(const f32x4*)(r_k + cc);
            const f32x4 kq = k * kk4; ss += (kq[0] * kq[0] + kq[1] * kq[1]) + (kq[2] * kq[2] + kq[3] * kq[3]);
            const f32x4 kds = k * (2.f + (af + ab - 2.f) * ka4);
            const f32x4 t = r * kds * rk4; bs += (t[0] + t[1]) + (t[2] + t[3]);
            if (l > 0) { const f32x4 v = ld_h4(V + oo), vf = ld_h4(VF + oo), vg = ld_h4(VG + oo); st_h4(V + oo, v + (vf - v) * vg); }
        }
        ss = quadsum(ss); bs = quadsum(bs);
        if ((T.lane & 3) == 0) { RN[(size_t)m * 16 + head] = 1.f / fmaxf(sqrtf(ss), 1e-12f); BS[(size_t)m * 16 + head] = bs; }
    }
}
FI void ph_rwscan(const TI& T, int l, int vslot, int ybslot) {
    unsigned char* ws = PWS;
    constexpr int GS = 32, NG = (SEQ + CTXL) / GS, REC = 5 * 64 + 16;
    LAS float* ring = (LAS float*)T.lds;
    const float* RN = (const float*)(ws + WS_RN);
    for (int ct = T.vb; ct < 256; ct += gridDim.x) {
        const int chain = ct >> 2, rq = ct & 3, b = chain >> 5, h = (chain >> 1) & 15, dir = chain & 1, hc = h * 64;
        const int cbase = ML + b * CTXL, lbase = b * SEQ;
#define RW_ROW(s) ((s) < CTXL ? (dir ? cbase + CTXL - 1 - (s) : cbase + (s)) : (dir ? lbase + SEQ - 1 - ((s) - CTXL) : lbase + ((s) - CTXL)))
        if (T.wave >= 4) {
            const int pw = T.wave - 4, lane = T.lane;
            const f16* Rp = sloth(ws, 5) + hc + lane; const f16* Kp = sloth(ws, 6) + hc + lane; const f16* Vp = sloth(ws, vslot) + hc + rq * 16 + (lane & 15);
            const f16* Op = sloth(ws, dir ? 3 : 1) + hc + lane; const f16* Ap = sloth(ws, dir ? 4 : 2) + hc + lane;
            const float kkc = PIN(27)[l * 1024 + hc + lane], kac = PIN(28)[l * 1024 + hc + lane], rkc = PIN(29)[l * 1024 + hc + lane];
            float* __restrict__ BSd = (float*)(ws + (dir ? WS_BSB : WS_BSUM));
            f16 cr[8], ck[8], co[8], ca[8], cv[8]; float crn[8];
            f16 nr[8], nk[8], no[8], na[8], nv[8]; float nrn[8];
#define RW_LOAD(R_, K_, O_, A_, V_, N_, g_) { _Pragma("unroll") for (int u = 0; u < 8; ++u) { const int mm = RW_ROW((g_) * GS + pw * 8 + u); const size_t ro = (size_t)mm * 1024; \
                R_[u] = Rp[ro]; K_[u] = Kp[ro]; O_[u] = Op[ro]; A_[u] = Ap[ro]; V_[u] = Vp[ro]; N_[u] = RN[(size_t)mm * 16 + h]; } }
#define RW_CONV(R_, K_, O_, A_, V_, N_, buf_, g_) { _Pragma("unroll") for (int u = 0; u < 8; ++u) { LAS float* rec = ring + ((buf_) * GS + pw * 8 + u) * REC; \
                const float k = (float)K_[u], a = (float)A_[u]; const float kk = k * (kkc * N_[u]); const float kd = k * (1.f + (a - 1.f) * kac), rr = (float)R_[u]; \
                rec[lane] = kk; rec[64 + lane] = -(kk * a); rec[128 + lane] = kd; rec[192 + lane] = 1.f - (float)O_[u]; rec[256 + lane] = rr; if (lane < 16) rec[320 + lane] = (float)V_[u]; \
                if (rq == 0) { const float bs = wave_sum(rr * kd * rkc, lane); if (lane == 0) BSd[(size_t)RW_ROW((g_) * GS + pw * 8 + u) * 16 + h] = bs; } } }
            RW_LOAD(cr, ck, co, ca, cv, crn, 0);
            RW_CONV(cr, ck, co, ca, cv, crn, 0, 0);
            RW_LOAD(cr, ck, co, ca, cv, crn, 1);
            __syncthreads();
            for (int g = 0; g < NG; ++g) {
                if (g + 2 < NG) RW_LOAD(nr, nk, no, na, nv, nrn, g + 2);
                if (g + 1 < NG) RW_CONV(cr, ck, co, ca, cv, crn, (g + 1) & 1, g + 1);
#pragma unroll
                for (int u = 0; u < 8; ++u) { cr[u] = nr[u]; ck[u] = nk[u]; co[u] = no[u]; ca[u] = na[u]; cv[u] = nv[u]; crn[u] = nrn[u]; }
                __syncthreads();
            }
#undef RW_LOAD
#undef RW_CONV
        } else {
            const int vl = T.wave * 4 + (T.lane >> 4), kq = (T.lane & 15) * 4;
            GAS bf16* Yp = (GAS bf16*)(slotb(ws, dir ? ybslot : 0) + hc + rq * 16 + vl);
            const bool wr = (T.lane & 15) == 0;
            f32x4 S = {0.f, 0.f, 0.f, 0.f};
            __syncthreads();
            for (int g = 0; g < NG; ++g) {
                const LAS float* rec = ring + ((g & 1) * GS) * REC;
                const int m0 = RW_ROW(g * GS); const long ystep = dir ? -1024 : 1024;
                GAS bf16* yp = Yp + (size_t)m0 * 1024;
                f32x4 kk[3], bb[3], kd[3], w[3], r[3]; float v[3];
#define RW_LDREC(j_, s_) { const LAS float* q_ = rec + (s_) * REC; kk[j_] = *(const LAS f32x4*)(q_ + kq); bb[j_] = *(const LAS f32x4*)(q_ + 64 + kq); kd[j_] = *(const LAS f32x4*)(q_ + 128 + kq); \
                    w[j_] = *(const LAS f32x4*)(q_ + 192 + kq); r[j_] = *(const LAS f32x4*)(q_ + 256 + kq); v[j_] = q_[320 + vl]; }
                RW_LDREC(0, 0); RW_LDREC(1, 1);
                const int lb0 = T.lane & 1, lb1 = (T.lane >> 1) & 1;
                const long yoff = (long)(lb1 + 2 * lb0) * ystep;
                const bool wr4 = (T.lane & 15) < 4;
                float p[4];
#pragma unroll
                for (int si = 0; si < GS; ++si) {
                    if (si + 2 < GS) RW_LDREC((si + 2) % 3, si + 2);
                    const int j = si % 3;
                    float d = (S[0] * kk[j][0] + S[1] * kk[j][1]) + (S[2] * kk[j][2] + S[3] * kk[j][3]);
                    const f32x4 base = S * w[j] + v[j] * kd[j];
                    d = allred16(d);
                    S = base + d * bb[j];
                    p[si & 3] = (S[0] * r[j][0] + S[1] * r[j][1]) + (S[2] * r[j][2] + S[3] * r[j][3]);
                    if ((si & 3) == 3) {
                        float kA = lb0 ? p[2] : p[0], sA = lb0 ? p[0] : p[2], kB = lb0 ? p[3] : p[1], sB = lb0 ? p[1] : p[3];
                        kA += dppf<0xB1>(sA); kB += dppf<0xB1>(sB);
                        float kC = lb1 ? kB : kA, sC = lb1 ? kA : kB;
                        kC += dppf<0x4E>(sC);
                        kC += dppf<0x124>(kC); kC += dppf<0x128>(kC);
                        if (wr4) yp[yoff] = (bf16)f2bf(kC);
                        yp += 4 * ystep;
                    }
                }
#undef RW_LDREC
                __syncthreads();
            }
        }
#undef RW_ROW
        __syncthreads();
    }
}
FI void ph_rwpost(const TI& T, int l, int vslot, int ybslot) {
    unsigned char* ws = PWS; const float* __restrict__ lnw = PIN(30) + l * 1024; const float* __restrict__ lnb = PIN(31) + l * 1024; const float* __restrict__ BS = (const float*)(ws + WS_BSUM);
    const bf16* __restrict__ YF = slotb(ws, 0); const bf16* __restrict__ YB = slotb(ws, ybslot); const f16* __restrict__ V = sloth(ws, vslot); const bf16* __restrict__ G = slotb(ws, 1); bf16* __restrict__ OUT = slotb(ws, 5);
    const int c0 = T.lane * 16, head = T.lane >> 2;
#pragma unroll 2
    for (int m = T.gw; m < M; m += T.NGW) {
        const size_t o = (size_t)m * 1024 + c0; f32x4 y[4], v[4], g[4]; float s = 0.f;
#pragma unroll
        for (int q = 0; q < 4; ++q) { y[q] = ld_bf4(YF + o + 4 * q) + ld_bf4(YB + o + 4 * q); v[q] = ld_h4(V + o + 4 * q); g[q] = ld_bf4(G + o + 4 * q); s += (y[q][0] + y[q][1]) + (y[q][2] + y[q][3]); }
        const float bsm = BS[(size_t)m * 16 + head];
        const float mean = quadsum(s) * (1.f / 64.f); float vs = 0.f;
#pragma unroll
        for (int q = 0; q < 4; ++q) { y[q] -= mean; vs += (y[q][0] * y[q][0] + y[q][1] * y[q][1]) + (y[q][2] * y[q][2] + y[q][3] * y[q][3]); }
        const float rstd = rsqrtf(quadsum(vs) * (1.f / 64.f) + 64e-5f);
#pragma unroll
        for (int q = 0; q < 4; ++q) { const int cc = c0 + 4 * q;
            const f32x4 yn = y[q] * rstd * *(const f32x4*)(lnw + cc) + *(const f32x4*)(lnb + cc);
            st_bf4(OUT + o + 4 * q, (yn + bsm * v[q]) * g[q]); }
    }
}

FI void ph_natten(const TI& T, int l, bool ctx_out) {
    unsigned char* ws = PWS; const bf16* Q = slotb(ws, 1); const bf16* Kb = slotb(ws, 2); const bf16* Vt = slotb(ws, 3); bf16* Y = slotb(ws, 1);
    const int fr = T.lane & 15, fq = T.lane >> 4, w = T.wave, tid = T.tid;
    LAS unsigned char* Kl = T.lds; LAS unsigned char* Vl = T.lds + 9216;
    const int ntasks = 1024 + (ctx_out ? 32 : 0);
    const int lrow = tid >> 3, lpc = tid & 7;
    for (int task = T.vb; task < ntasks; task += gridDim.x) {
        const bool cq = task >= 1024; int b, h, r = 0, half = 0, qrow0, U0, nwin;
        if (!cq) { const int rg = task & 31; h = (task >> 5) & 15; b = task >> 9; r = rg * 4 + (w >> 1); half = w & 1; qrow0 = b * SEQ + r * 64 + half * 32;
                   U0 = min(max(rg * 4 - 4, 0), 120); nwin = min(max(rg * 4 + 3 - 4, 0), 120) + 8 - U0; }
        else { const int t2 = task - 1024; h = t2 & 15; b = t2 >> 4; qrow0 = ML + b * CTXL + w * 32; U0 = 0; nwin = 0; }
        const int nch = nwin + 4; const int r0 = min(max(r - 4, 0), 120);
        const float* rpb = PIN(9) + ((size_t)l * 16 + h) * 15 * 31;
        LAS float* RL = (LAS float*)(T.lds + 18432);
        __syncthreads();
        if (tid < 465) RL[tid] = rpb[tid];
        bf16x8 Qf[2][2];
#pragma unroll
        for (int qt = 0; qt < 2; ++qt)
#pragma unroll
            for (int ks = 0; ks < 2; ++ks) Qf[qt][ks] = *(const bf16x8*)(Q + (size_t)(qrow0 + qt * 16 + fr) * 1024 + h * 64 + ks * 32 + fq * 8);
        f32x4 O[2][4]; float mr[2], lr[2];
#pragma unroll
        for (int qt = 0; qt < 2; ++qt) { mr[qt] = -1e30f; lr[qt] = 0.f;
#pragma unroll
            for (int dt = 0; dt < 4; ++dt) O[qt][dt] = (f32x4){0.f, 0.f, 0.f, 0.f}; }
#define NAT_GLOAD(c_, kreg_, vreg_) { const bool w_ = (c_) < nwin; const int kr_ = U0 + (c_), cc_ = (c_) - nwin; \
            const bf16* kp_ = w_ ? Kb + (size_t)(b * SEQ + kr_ * 64 + lrow) * 1024 + h * 64 + lpc * 8 : Kb + (size_t)(ML + b * CTXL + cc_ * 64 + lrow) * 1024 + h * 64 + lpc * 8; \
            const bf16* vp_ = w_ ? Vt + ((size_t)(b * 16 + h) * 64 + lrow) * SEQ + kr_ * 64 + lpc * 8 : Vt + (size_t)ML * 1024 + ((size_t)(b * 16 + h) * 64 + lrow) * CTXL + cc_ * 64 + lpc * 8; \
            kreg_ = *(const u32x4*)kp_; vreg_ = *(const u32x4*)vp_; }
        u32x4 kreg, vreg;
        NAT_GLOAD(0, kreg, vreg);
        for (int c = 0; c < nch; ++c) {
            __syncthreads();
            *(LAS u32x4*)(Kl + lrow * 144 + lpc * 16) = kreg; *(LAS u32x4*)(Vl + lrow * 144 + lpc * 16) = vreg;
            __syncthreads();
            if (c + 1 < nch) NAT_GLOAD(c + 1, kreg, vreg);
            const bool win = c < nwin; const int kr = U0 + c;
            const bool active = win ? (kr >= r0 && kr < r0 + 8) : true;
            if (active) {
                f32x4 s[2][4];
                const int ktskip = win ? (half ? 0 : 3) : -1;
#pragma unroll
                for (int kt = 0; kt < 4; ++kt) {
                    if (kt == ktskip) { s[0][kt] = (f32x4){-1e30f, -1e30f, -1e30f, -1e30f}; s[1][kt] = s[0][kt]; continue; }
                    const bf16x8 k0 = *(const LAS bf16x8*)(Kl + (kt * 16 + fr) * 144 + fq * 16), k1 = *(const LAS bf16x8*)(Kl + (kt * 16 + fr) * 144 + 64 + fq * 16);
#pragma unroll
                    for (int qt = 0; qt < 2; ++qt) { f32x4 a = {0.f, 0.f, 0.f, 0.f}; a = __builtin_amdgcn_mfma_f32_16x16x32_bf16(k0, Qf[qt][0], a, 0, 0, 0); a = __builtin_amdgcn_mfma_f32_16x16x32_bf16(k1, Qf[qt][1], a, 0, 0, 0); s[qt][kt] = a; }
                }
                bf16x8 Pf[2][2];
#pragma unroll
                for (int qt = 0; qt < 2; ++qt) {
                    float mx = -1e30f;
                    if (win) {
                        const int qcol = half * 32 + qt * 16 + fr, c0 = min(max(qcol - 8, 0), 48); const LAS float* rp = RL + (kr - r + 7) * 31;
                        const int tl = fq * 4 - c0, dl = fq * 4 - qcol + 15;
#pragma unroll
                        for (int kt = 0; kt < 4; ++kt) {
                            if (kt == ktskip) continue;
#pragma unroll
                            for (int j = 0; j < 4; ++j) { const int t = (kt * 16 + j) + tl; const int oob = (t | (15 - t)) >> 31;
                                const int dc = min(max((kt * 16 + j) + dl, 0), 30); const float val = s[qt][kt][j] * 0.125f + rp[dc];
                                const float mval = __builtin_bit_cast(float, (__builtin_bit_cast(int, val) & ~oob) | (0xf149f2ca & oob));
                                s[qt][kt][j] = mval; mx = fmaxf(mx, mval); }
                        }
                    } else {
#pragma unroll
                        for (int kt = 0; kt < 4; ++kt)
#pragma unroll
                            for (int j = 0; j < 4; ++j) { const float val = s[qt][kt][j] * 0.125f; s[qt][kt][j] = val; mx = fmaxf(mx, val); }
                    }
                    mx = max_fq(mx);
                    const float mnew = fmaxf(mr[qt], mx), alpha = __expf(mr[qt] - mnew); mr[qt] = mnew; float ps = 0.f;
#pragma unroll
                    for (int kt = 0; kt < 4; ++kt)
#pragma unroll
                        for (int j = 0; j < 4; ++j) { const float p = __expf(s[qt][kt][j] - mnew); s[qt][kt][j] = p; ps += p; }
                    lr[qt] = lr[qt] * alpha + ps;
#pragma unroll
                    for (int dt = 0; dt < 4; ++dt) O[qt][dt] *= alpha;
#pragma unroll
                    for (int s2 = 0; s2 < 2; ++s2) { u32x4 pw; pw.x = pk2(s[qt][2 * s2][0], s[qt][2 * s2][1]); pw.y = pk2(s[qt][2 * s2][2], s[qt][2 * s2][3]); pw.z = pk2(s[qt][2 * s2 + 1][0], s[qt][2 * s2 + 1][1]); pw.w = pk2(s[qt][2 * s2 + 1][2], s[qt][2 * s2 + 1][3]);
                        Pf[qt][s2] = __builtin_bit_cast(bf16x8, pw); }
                }
#pragma unroll
                for (int dt = 0; dt < 4; ++dt)
#pragma unroll
                    for (int s2 = 0; s2 < 2; ++s2) {
                        const LAS unsigned char* vp = Vl + (dt * 16 + fr) * 144 + (2 * s2 * 16 + fq * 4) * 2;
                        const u32x2 lo = *(const LAS u32x2*)vp, hi = *(const LAS u32x2*)(vp + 32);
                        u32x4 vw; vw.x = lo.x; vw.y = lo.y; vw.z = hi.x; vw.w = hi.y; const bf16x8 Vf = __builtin_bit_cast(bf16x8, vw);
#pragma unroll
                        for (int qt = 0; qt < 2; ++qt) O[qt][dt] = __builtin_amdgcn_mfma_f32_16x16x32_bf16(Vf, Pf[qt][s2], O[qt][dt], 0, 0, 0);
                    }
            }
        }
#undef NAT_GLOAD
#pragma unroll
        for (int qt = 0; qt < 2; ++qt) { float lt = sum_fq(lr[qt]); const float inv = 1.f / lt;
#pragma unroll
            for (int dt = 0; dt < 4; ++dt) st_bf4(Y + (size_t)(qrow0 + qt * 16 + fr) * 1024 + h * 64 + dt * 16 + fq * 4, O[qt][dt] * inv); }
    }
}

FI void ph_conv(const TI& T, int l) {
    unsigned char* ws = PWS; const float* __restrict__ cw = PIN(10) + (size_t)l * 4 * 1024; const float* __restrict__ cb = PIN(11) + l * 1024;
    const bf16* __restrict__ U = slotb(ws, 2); bf16* __restrict__ UC = slotb(ws, 4);
#pragma unroll 4
    for (int it = T.gtid; it < M * 256; it += T.NT) {
        const int m = it >> 8, cc = (it & 255) * 4; int s0, len, pos; seq_of(m, s0, len, pos);
        f32x4 acc = *(const f32x4*)(cb + cc);
#pragma unroll
        for (int j = 0; j < 4; ++j) { const int pp = pos + j - 2; const bool ok = pp >= 0 && pp < len; const f32x4 x = ld_bf4(U + (size_t)(s0 + (ok ? pp : pos)) * 1024 + cc); acc += (ok ? 1.f : 0.f) * (*(const f32x4*)(cw + j * 1024 + cc) * x); }
        st_bf4(UC + (size_t)m * 1024 + cc, acc);
    }
}
typedef _Float16 f16x2 __attribute__((ext_vector_type(2)));
FI void ph_rgscan1(const TI& T, int l) {
    unsigned char* ws = PWS; f32x2* __restrict__ AB = (f32x2*)(ws + WS_A2);
    for (int it = T.gtid; it < 2 * 264 * 512; it += T.NT) {
        const int c = (it & 511) * 2, q = (it >> 9) % 264, dir = it / (264 * 512);
        const f16* __restrict__ OM = sloth(ws, dir ? 2 : 6); const f16* __restrict__ BB = sloth(ws, dir ? (l == 0 ? 0 : 8) : 7);
        float Ap0 = 1.f, Bp0 = 0.f, Ap1 = 1.f, Bp1 = 0.f;
#pragma unroll 16
        for (int i = 0; i < 64; ++i) { const int m = q * 64 + (dir ? 63 - i : i); const size_t o = (size_t)m * 1024 + c; const f16x2 om = *(const f16x2*)(OM + o), b = *(const f16x2*)(BB + o);
            const float a0 = 1.f - (float)om[0], a1 = 1.f - (float)om[1]; Ap0 *= a0; Bp0 = a0 * Bp0 + (float)b[0]; Ap1 *= a1; Bp1 = a1 * Bp1 + (float)b[1]; }
        const size_t oi = ((size_t)dir * 264 + q) * 1024 + c; AB[oi] = (f32x2){Ap0, Bp0}; AB[oi + 1] = (f32x2){Ap1, Bp1};
    }
}
FI void ph_rgscan2(const TI& T) {
    unsigned char* ws = PWS; const f32x2* AB = (const f32x2*)(ws + WS_A2); float* HIN = (float*)(ws + WS_A2 + (size_t)2 * 264 * 1024 * 8);
    for (int it = T.gtid; it < 4096; it += T.NT) {
        const int c = it & 1023, b = (it >> 10) & 1, dir = it >> 11; float h = 0.f;
        for (int i0 = 0; i0 < 132; i0 += 33) {
            f32x2 ab[33]; int qq[33];
#pragma unroll
            for (int u = 0; u < 33; ++u) { const int i = i0 + u; int q; if (i < 4) q = 256 + b * 4 + (dir ? 3 - i : i); else q = b * 128 + (dir ? 127 - (i - 4) : (i - 4)); qq[u] = q; ab[u] = AB[((size_t)dir * 264 + q) * 1024 + c]; }
#pragma unroll
            for (int u = 0; u < 33; ++u) { HIN[((size_t)dir * 264 + qq[u]) * 1024 + c] = h; h = ab[u].x * h + ab[u].y; }
        }
    }
}
FI void ph_rgscan3(const TI& T, int l) {
    unsigned char* ws = PWS; const float* __restrict__ HIN = (const float*)(ws + WS_A2 + (size_t)2 * 264 * 1024 * 8);
    bf16* __restrict__ UC = slotb(ws, 4); const bf16* __restrict__ GUG = slotb(ws, 3);
    const f16* __restrict__ OMF = sloth(ws, 6); const f16* __restrict__ BBF = sloth(ws, 7); const f16* __restrict__ OMB = sloth(ws, 2); const f16* __restrict__ BBB = sloth(ws, l == 0 ? 0 : 8);
    for (int it = T.gtid; it < 264 * 512; it += T.NT) {
        const int c = (it & 511) * 2, q = it >> 9; const size_t ob = (size_t)(q * 64) * 1024 + c;
        unsigned hfr[64];
        float h0 = HIN[((size_t)0 * 264 + q) * 1024 + c], h1 = HIN[((size_t)0 * 264 + q) * 1024 + c + 1];
#define RS3_F(I0) { f16x2 om[16], b[16]; \
            _Pragma("unroll") for (int u = 0; u < 16; ++u) { om[u] = *(const f16x2*)(OMF + ob + (size_t)((I0) + u) * 1024); b[u] = *(const f16x2*)(BBF + ob + (size_t)((I0) + u) * 1024); } \
            _Pragma("unroll") for (int u = 0; u < 16; ++u) { h0 = (h0 - (float)om[u][0] * h0) + (float)b[u][0]; h1 = (h1 - (float)om[u][1] * h1) + (float)b[u][1]; hfr[(I0) + u] = pk2(h0, h1); } }
        RS3_F(0) RS3_F(16) RS3_F(32) RS3_F(48)
#undef RS3_F
        h0 = HIN[((size_t)1 * 264 + q) * 1024 + c]; h1 = HIN[((size_t)1 * 264 + q) * 1024 + c + 1];
#define RS3_B(I0) { f16x2 om[16], b[16]; unsigned gg[16]; \
            _Pragma("unroll") for (int u = 0; u < 16; ++u) { const size_t o = ob + (size_t)(63 - (I0) - u) * 1024; om[u] = *(const f16x2*)(OMB + o); b[u] = *(const f16x2*)(BBB + o); gg[u] = *(const unsigned*)(GUG + o); } \
            _Pragma("unroll") for (int u = 0; u < 16; ++u) { const size_t o = ob + (size_t)(63 - (I0) - u) * 1024; const unsigned hf = hfr[63 - (I0) - u]; \
                h0 = (h0 - (float)om[u][0] * h0) + (float)b[u][0]; h1 = (h1 - (float)om[u][1] * h1) + (float)b[u][1]; \
                *(unsigned*)(UC + o) = pk2((bf2f(hf & 0xffffu) + h0) * bf2f(gg[u] & 0xffffu), (bf2f(hf >> 16) + h1) * bf2f(gg[u] >> 16)); } }
        RS3_B(0) RS3_B(16) RS3_B(32) RS3_B(48)
#undef RS3_B
    }
}

enum { G_RW = 0, G_NAT, G_LRU, G_GATE, G_BRA, G_BRB, G_BRC, G_OUT, G_FF1, G_FF2 };
struct EpiAll {
    static constexpr bool PERM = false, AFTER_DRAIN = false;
    int mode, l; LAS unsigned char* lds;
    FI void one(unsigned char* ws, float* out, const float* x_in, const float* ctx_in, int row, int col, f32x4 v0, f32x4 v1) const {
        const float* MODl_ = (const float*)(ws + WS_MOD) + (size_t)l * 3 * 6144;
        switch (mode) {
            case G_RW: FRw{ws}(row, col, v0, v1); break;
            case G_NAT: FNat{ws, (const float*)(ws + WS_ROPE)}(row, col, v0, v1); break;
            case G_LRU: FLru{ws}(row, col, v0, v1); break;
            case G_GATE: FGate{ws}(row, col, v0, v1); break;
            case G_BRA: FBr<0>{slotb(ws, 2), slotb(ws, 7)}(row, col, v0, v1); break;
            case G_BRB: FBr<1>{slotb(ws, 3), slotb(ws, 7)}(row, col, v0, v1); break;
            case G_BRC: FBr<2>{slotb(ws, 6), slotb(ws, 7)}(row, col, v0, v1); break;
            case G_OUT: FRes{l == 0 ? x_in : (const float*)out, out, l == 0 ? ctx_in : (const float*)(ws + WS_XCTX), (float*)(ws + WS_XCTX), MODl_ + 2048, l == 0}(row, col, v0, v1); break;
            case G_FF1: FFf1{slotb(ws, 1)}(row, col, v0, v1); break;
            default: FRes{(const float*)out, out, (const float*)(ws + WS_XCTX), (float*)(ws + WS_XCTX), MODl_ + 5120, l == 0}(row, col, v0, v1); break;
        }
    }
    FI void operator()(const pg8::f32x4 (&acc)[2][2][4][2], const pg8::Unit& u, int wr, int wc, int fr, int fq) const {
        unsigned char* ws = (unsigned char*)ldsptr(lds, 44); float* out = (float*)ldsptr(lds, 43); const float* x_in = ldsptr(lds, 0); const float* ctx_in = ldsptr(lds, 2);
#pragma unroll
        for (int ai = 0; ai < 2; ++ai)
#pragma unroll
            for (int m = 0; m < 4; ++m) { const int row = u.pm * 256 + ai * 128 + wr * 64 + m * 16 + fr;
#pragma unroll
                for (int bj = 0; bj < 2; ++bj) { const int col = u.pn * 256 + bj * 128 + wc * 32 + 4 * fq; one(ws, out, x_in, ctx_in, row, col, acc[ai][bj][m][0], acc[ai][bj][m][1]); }
                asm volatile("" ::: "memory"); }
    }
};
FI void run_gemm_all(const TI& T, int mode, int l) {
    unsigned char* ws = PWS;
    int aslot = 0, N = 1024, K = 1024; size_t boff = WS_WIN;
    switch (mode) {
        case G_RW: boff = WS_WIN + (size_t)5120 * 2048; N = 4096; break;
        case G_NAT: N = 3072; break;
        case G_LRU: boff = WS_WIN + (size_t)3072 * 2048; N = 2048; break;
        case G_GATE: boff = WS_WIN + (size_t)9216 * 2048; N = 3072; break;
        case G_BRA: aslot = 1; boff = WS_WBR; break;
        case G_BRB: aslot = 4; boff = WS_WBR + (size_t)1024 * 2048; break;
        case G_BRC: aslot = 5; boff = WS_WBR + (size_t)2048 * 2048; break;
        case G_OUT: aslot = 7; boff = WS_WOUT; break;
        case G_FF1: N = 4096; break;
        default: aslot = 1; boff = WS_WIN + (size_t)4096 * 2048; K = 4096; break;
    }
    const bf16* Abase = (l == 0 && mode <= G_GATE) ? (const bf16*)POUT : slotb(ws, aslot);
    pg8::Gemm g{Abase, (const bf16*)(ws + boff), ML, N, K}; pg8::StaticOrder S; S.init(ML, N, (int)gridDim.x, (int)blockIdx.x);
    EpiAll E{mode, l, T.lds};
    pg8::gemm_phase<EpiAll, pg8::StaticOrder, true, true>((PG8_LAS unsigned char*)T.lds, g, S, E);
    if (l == 1 && mode >= G_GATE) return;
    {
        const bf16* A = Abase + (size_t)ML * K; const bf16* Bt = (const bf16*)(ws + boff);
        const int fr = T.lane & 15, fq = T.lane >> 4, nct = N >> 6, nitems = 8 * nct, kw = K >> 3;
        LAS float* red = (LAS float*)T.lds;
        unsigned char* ws2 = ws; float* out = POUT; const float* x_in = PIN(0); const float* ctx_in = PIN(2);
        for (int it = T.vb; it < nitems; it += gridDim.x) {
            const int rt = it / nct, ct = it % nct, row0 = rt * 64, col0 = ct * 64, kbeg = T.wave * kw;
            f32x4 acc[4][4];
#pragma unroll
            for (int m = 0; m < 4; ++m)
#pragma unroll
                for (int n = 0; n < 4; ++n) acc[m][n] = (f32x4){0.f, 0.f, 0.f, 0.f};
            for (int k0 = kbeg; k0 < kbeg + kw; k0 += 128) {
                bf16x8 af[4][4], bfr[4][4];
#pragma unroll
                for (int ks = 0; ks < 4; ++ks) {
#pragma unroll
                    for (int m = 0; m < 4; ++m) af[ks][m] = *(const bf16x8*)(A + (size_t)(row0 + 16 * m + fr) * K + k0 + ks * 32 + fq * 8);
#pragma unroll
                    for (int n = 0; n < 4; ++n) bfr[ks][n] = *(const bf16x8*)(Bt + (size_t)(col0 + 16 * n + fr) * K + k0 + ks * 32 + fq * 8);
                }
#pragma unroll
                for (int ks = 0; ks < 4; ++ks)
#pragma unroll
                    for (int m = 0; m < 4; ++m)
#pragma unroll
                        for (int n = 0; n < 4; ++n) acc[m][n] = __builtin_amdgcn_mfma_f32_16x16x32_bf16(bfr[ks][n], af[ks][m], acc[m][n], 0, 0, 0);
            }
            { LAS float* dst = red + T.wave * 4096 + T.lane;
#pragma unroll
              for (int m = 0; m < 4; ++m)
#pragma unroll
                  for (int n = 0; n < 4; ++n)
#pragma unroll
                      for (int j = 0; j < 4; ++j) dst[((m * 4 + n) * 4 + j) * 64] = acc[m][n][j]; }
            __syncthreads();
            { const int m = T.wave >> 1, np = T.wave & 1; f32x4 s0 = {0.f, 0.f, 0.f, 0.f}, s1 = {0.f, 0.f, 0.f, 0.f};
#pragma unroll
              for (int w = 0; w < 8; ++w) { const LAS float* src = red + w * 4096 + T.lane;
#pragma unroll
                  for (int j = 0; j < 4; ++j) { s0[j] += src[((m * 4 + 2 * np) * 4 + j) * 64]; s1[j] += src[((m * 4 + 2 * np + 1) * 4 + j) * 64]; } }
              E.one(ws2, out, x_in, ctx_in, ML + row0 + 16 * m + fr, col0 + 32 * np + 4 * fq, s0, s1); }
            __syncthreads();
        }
    }
}

#define XB_TMO      128
#define XB_XCNT(j)  (256  + 64 * (j))
#define XB_XSUB(j)  (1280 + 64 * (j))
#define XB_XGEN(j)  (2304 + 64 * (j))
#define XB_TOP      3328
#define XB_TOPGEN   3392
#define XCD_BAR_WORDS 3456
#define XB_SPIN_CAP (1u << 18)

__device__ __forceinline__ unsigned xb_ld(unsigned* p)              { return __hip_atomic_load(p, __ATOMIC_RELAXED, __HIP_MEMORY_SCOPE_AGENT); }
__device__ __forceinline__ unsigned xb_add(unsigned* p, unsigned v) { return __hip_atomic_fetch_add(p, v, __ATOMIC_RELAXED, __HIP_MEMORY_SCOPE_AGENT); }
__device__ __forceinline__ unsigned xb_xcc_id() { return (unsigned)__builtin_amdgcn_s_getreg((3 << 11) | 20) & 0xFu; }
#define XB_SPIN(cond, bar) do { unsigned _sp = 0; while (cond) { __builtin_amdgcn_s_sleep(1); \
    if ((++_sp & 255u) == 0u) { if (xb_ld(&(bar)[XB_TMO])) break; if (_sp > XB_SPIN_CAP) { atomicAdd(&(bar)[XB_TMO], 1u); break; } } } } while (0)

struct XcdBarrier {
    unsigned* bar; unsigned x;
    volatile LAS unsigned* st;
};

__device__ __forceinline__ XcdBarrier xcd_barrier_post(unsigned* bar, volatile LAS unsigned* st) {
    XcdBarrier b; b.bar = bar; b.x = xb_xcc_id(); b.st = st;
    if (threadIdx.x == 0) (void)xb_add(&bar[XB_XCNT(b.x)], 1u);
    return b;
}
__device__ __forceinline__ void xcd_barrier_complete(unsigned* bar, unsigned x, unsigned& nloc, unsigned& nx) {
    const unsigned G = gridDim.x * gridDim.y * gridDim.z;
    unsigned sum, cnt, mine, sp = 0u;
    for (;;) {
        sum = 0u; cnt = 0u; mine = 0u;
#pragma unroll
        for (unsigned j = 0; j < 16; ++j) { const unsigned c = xb_ld(&bar[XB_XCNT(j)]); sum += c; cnt += (c > 0u) ? 1u : 0u; mine = (j == x) ? c : mine; }
        if (sum == G) break;
        __builtin_amdgcn_s_sleep(1);
        if ((++sp & 255u) == 0u) { if (xb_ld(&bar[XB_TMO])) break; if (sp > XB_SPIN_CAP) { atomicAdd(&bar[XB_TMO], 1u); break; } }
    }
    nloc = mine > 0u ? mine : 1u; nx = cnt > 0u ? cnt : 1u;
}

__device__ __forceinline__ void xcd_barrier(const XcdBarrier& b) {
    asm volatile("s_waitcnt vmcnt(0)" ::: "memory");
    __syncthreads();
    if (threadIdx.x == 0) {
        unsigned* bar = b.bar;
        __builtin_amdgcn_s_waitcnt(0);
        unsigned nloc = b.st[0], nx = b.st[1];
        if (nloc == 0u) { xcd_barrier_complete(bar, b.x, nloc, nx); b.st[0] = nloc; b.st[1] = nx; }
        const unsigned old = xb_add(&bar[XB_XSUB(b.x)], 1u);
        const unsigned gen = old / nloc;
        if (old + 1u == (gen + 1u) * nloc) {
            __builtin_amdgcn_fence(__ATOMIC_RELEASE, "agent");
            asm volatile("s_waitcnt vmcnt(0)" ::: "memory");
            const unsigned og = xb_add(&bar[XB_TOP], 1u);
            const unsigned tg = og / nx;
            if (og + 1u == (tg + 1u) * nx) xb_add(&bar[XB_TOPGEN], 1u);
            else XB_SPIN(xb_ld(&bar[XB_TOPGEN]) == tg, bar);
            __builtin_amdgcn_fence(__ATOMIC_ACQUIRE, "agent");
            xb_add(&bar[XB_XGEN(b.x)], 1u);
            asm volatile("s_waitcnt vmcnt(0)" ::: "memory");
        } else {
            XB_SPIN(xb_ld(&bar[XB_XGEN(b.x)]) == gen, bar);
            __builtin_amdgcn_fence(__ATOMIC_ACQUIRE, "agent");
            asm volatile("s_waitcnt vmcnt(0)" ::: "memory");
        }
    }
    __syncthreads();
}

enum { P_MOD = 0, P_PREP, P_SHIFT, P_LR2, P_RWPREP, P_SCAN, P_GG, P_RWPOST, P_NORM1, P_NAT, P_CONV, P_RGG, P_RS1, P_RS2, P_RS3, P_NORM2W, P_FINAL, P_NOP, P_GEMM0   };
#define PG(g) (P_GEMM0 + (g))
#define NOSYNC 64
#ifndef PROBE_EXTRA
#define PROBE_EXTRA(L)
#endif
#ifndef PB_NAT
#define PB_NAT(L)
#endif
#ifndef PB_GRW
#define PB_GRW(L)
#endif
#ifndef PB_SMALL1
#define PB_SMALL1(L)
#define PB_SMALL2(L)
#define PB_SMALL3(L)
#endif
#ifndef DUPP
#define DUPP(x)
#endif
#ifndef DUPG
#define DUPG(x)
#endif
#ifndef DUPS
#define DUPS(x)
#endif
#ifndef DUPA
#define DUPA(x)
#endif
#ifndef DUPC
#define DUPC(x)
#endif
#ifndef DUPB
#define DUPB(x)
#endif
#ifndef DUP
#define DUP(x)
#endif
#define NORM1A(L) NORM1A_##L
#define NORM1A_0
#define NORM1A_32 32 | P_NORM1,
#define LAYER(L) (L) | P_PREP, DUPP((L) | P_PREP) (L) | PG(G_RW), PB_GRW(L) (L) | P_SHIFT, DUPA((L) | P_SHIFT) (L) | P_LR2, DUPB((L) | P_LR2) (L) | P_SCAN, DUPS((L) | P_SCAN) (L) | P_RWPOST, DUPA((L) | P_RWPOST) NORM1A(L) (L) | PG(G_NAT), (L) | P_NAT, PB_NAT(L) \
    (L) | PG(G_LRU), (L) | P_CONV, DUPA((L) | P_CONV) (L) | P_RGG, DUPB((L) | P_RGG) (L) | P_RS2, DUPC((L) | P_RS2) (L) | P_RS3, (L) | PG(G_GATE), (L) | PG(G_BRA) | NOSYNC, DUPG((L) | PG(G_BRA) | NOSYNC) (L) | PG(G_BRB) | NOSYNC, (L) | PG(G_BRC), \
    (L) | PG(G_OUT), (L) | P_NORM2W, DUPP((L) | P_NORM2W) (L) | PG(G_FF1), (L) | PG(G_FF2), PROBE_EXTRA(L)
__constant__ unsigned char PROG[] = { P_MOD, LAYER(0) LAYER(32) 32 | P_FINAL };

__global__ void __launch_bounds__(NTHR, 2) mega(Params P) {
    extern __shared__ __attribute__((aligned(16))) unsigned char lds_raw[];
    cg::grid_group grid = cg::this_grid();
    LAS unsigned char* const lds0 = (LAS unsigned char*)lds_raw;
    { const int tid0 = threadIdx.x;
      LAS unsigned* tb = (LAS unsigned*)(lds0 + 131072);
      if (tid0 < 43) { const unsigned long long v = (unsigned long long)P.in[tid0]; tb[2 * tid0] = (unsigned)v; tb[2 * tid0 + 1] = (unsigned)(v >> 32); }
      if (tid0 == 43) { const unsigned long long v = (unsigned long long)P.out; tb[86] = (unsigned)v; tb[87] = (unsigned)(v >> 32); }
      if (tid0 == 44) { const unsigned long long v = (unsigned long long)P.ws; tb[88] = (unsigned)v; tb[89] = (unsigned)(v >> 32); } }
    { LAS unsigned* tb = (LAS unsigned*)(lds0 + 131072); if (threadIdx.x == 64) { tb[256] = 0u; tb[257] = 0u; } }
    __syncthreads();
    XcdBarrier xbar = xcd_barrier_post((unsigned*)(P.ws + WS_BAR), (volatile LAS unsigned*)(lds0 + 131072 + 1024));
    constexpr int NSTEPS = (int)sizeof(PROG);
    for (int st = 0; st < NSTEPS; ++st) {
        const unsigned code = PROG[st]; const int op = code & 31, l = (code >> 5) & 1;
        {
            const TI T = mk_ti(lds0);
            const int vslot = l == 0 ? 8 : 7, ybslot = l == 0 ? 7 : 8;
            unsigned char* ws = PWS;
            const bf16* L2 = (const bf16*)(ws + WS_WLR2); const bf16* A2 = (const bf16*)(ws + WS_A2);
            switch (op) {
                case P_MOD: ph_mod(T); ph_weights_mixer(T, 0); break;
                case P_PREP: if (l > 0) ph_weights_mixer(T, l); ph_norm(T, l, 0, l == 0 ? (bf16*)POUT : slotb(ws, 0)); break;
                case P_SHIFT: ph_shiftmix(T, l, vslot); break;
                case P_LR2:
                    sgemm<64>(T, A2, 448, 0, 4, L2 + LR2_ZF, 64, FLr2All{ws, PIN(19) + (size_t)l * 2048, PIN(22) + (size_t)l * 2048}, 4);
                    if (l > 0) sgemm_t<32, 2>(T, A2, 448, 416, 0, L2 + LR2_V, 16, FVmix{sloth(ws, vslot), sloth(ws, 8), PIN(32) + (l - 1) * 1024});
                    break;
                case P_RWPREP: ph_rwprep(T, l, vslot); break;
                case P_SCAN: ph_rwscan(T, l, vslot, ybslot); break;
                case P_GG: sgemm<160>(T, A2, 448, 256, 0, L2 + LR2_G, 16, FPlainB{slotb(ws, 1)}); break;
                case P_RWPOST: sgemm_t<160, 2>(T, A2, 448, 256, 0, L2 + LR2_G, 16, FPost{slotb(ws, 0), slotb(ws, ybslot), sloth(ws, vslot), slotb(ws, 5), (const float*)(ws + WS_BSUM), (const float*)(ws + WS_BSB), PIN(30) + l * 1024, PIN(31) + l * 1024, T.lane}); break;
                case P_NORM1: ph_norm(T, l, 0, slotb(ws, 0)); break;
                case P_NAT: ph_natten(T, l, l == 0); break;
                case P_CONV: ph_conv(T, l); break;
                case P_RGG: sgemm<64>(T, slotb(ws, 4), 1024, 0, 16, (const bf16*)(ws + WS_WRG), 64, FRgAB{ws, PIN(13) + (size_t)l * 2048, PIN(15) + (size_t)l * 2048, (const float*)(ws + WS_SP8), slotb(ws, 4), l == 0 ? 0 : 8, (LAS f32x2*)(T.lds + T.wave * 16384), T.lane}, 1); break;
                case P_RS1: ph_rgscan1(T, l); break;
                case P_RS2: ph_rgscan2(T); break;
                case P_RS3: ph_rgscan3(T, l); break;
                case P_NORM2W: ph_norm(T, l, 1, slotb(ws, 0)); ph_weights_mlp(T, l); break;
                case P_FINAL: ph_final(T); break;
                case P_NOP: break;
                default: run_gemm_all(T, op - P_GEMM0, l); break;
            }
        }
        if (!(code & NOSYNC) && st + 1 < NSTEPS) { if (P.ph_lo == 0x7fffffff) grid.sync();
            else { XcdBarrier b2; b2.bar = (unsigned*)(ldsptr(lds0, 44)) + WS_BAR / 4; b2.x = xb_xcc_id(); b2.st = (volatile LAS unsigned*)(lds0 + 131072 + 1024); xcd_barrier(b2); } }
    }
}

extern "C" void kernel_launch(void* const* d_in, const int* in_sizes, int n_in, void* d_out, int out_size, void* d_ws, size_t ws_size, hipStream_t stream) {
    static int grid = 0;
    if (grid == 0) {
        if (n_in != 43 || out_size != ML * 1024 || ws_size < WS_END) { fprintf(stderr, "kernel_launch: unexpected problem (n_in %d, out %d, ws %zu < %zu)\n", n_in, out_size, ws_size, (size_t)WS_END); grid = -1; return; }
        int dev = 0, cus = 0, per_cu = 0;
        (void)hipGetDevice(&dev); (void)hipDeviceGetAttribute(&cus, hipDeviceAttributeMultiprocessorCount, dev);
        if (hipFuncSetAttribute((const void*)mega, hipFuncAttributeMaxDynamicSharedMemorySize, LDS_BYTES) != hipSuccess) { fprintf(stderr, "kernel_launch: hipFuncSetAttribute failed\n"); grid = -1; return; }
        if (hipOccupancyMaxActiveBlocksPerMultiprocessor(&per_cu, (const void*)mega, NTHR, LDS_BYTES) != hipSuccess || per_cu < 1) { fprintf(stderr, "kernel_launch: occupancy query says %d\n", per_cu); grid = -1; return; }
        grid = cus;
    }
    if (grid < 0) return;
    Params p{};
    for (int i = 0; i < 43; ++i) p.in[i] = (const float*)d_in[i];
    p.out = (float*)d_out; p.ws = (unsigned char*)d_ws; p.ph_lo = 0; p.ph_hi = 1000;
    if (hipMemsetAsync((char*)d_ws + WS_BAR, 0, 16384, stream) != hipSuccess) { fprintf(stderr, "kernel_launch: memset failed\n"); return; }
    void* args[] = {&p};
    hipError_t e = hipLaunchCooperativeKernel((const void*)mega, dim3(grid), dim3(NTHR), args, LDS_BYTES, stream);
    if (e != hipSuccess) fprintf(stderr, "cooperative launch failed: %s (grid %d)\n", hipGetErrorString(e), grid);
}
```

```cpp
#include <hip/hip_runtime.h>
#include <hip/hip_cooperative_groups.h>
#include <cstdio>
#include <cstdint>
namespace cg = cooperative_groups;

#define GAS __attribute__((address_space(1)))
#define LAS __attribute__((address_space(3)))
typedef unsigned short bf16;
typedef _Float16 f16;
typedef float f32x4 __attribute__((ext_vector_type(4)));
typedef float f32x2 __attribute__((ext_vector_type(2)));
typedef short bf16x8 __attribute__((ext_vector_type(8)));
typedef short s16x4 __attribute__((ext_vector_type(4)));
typedef _Float16 f16x4 __attribute__((ext_vector_type(4)));
typedef unsigned u32x2 __attribute__((ext_vector_type(2)));
typedef unsigned u32x4 __attribute__((ext_vector_type(4)));
#define LDS_WAIT() asm volatile("s_waitcnt lgkmcnt(0)" ::: "memory")

constexpr int DM = 1024, SEQ = 8192, CTXL = 256, ML = 16384, MC = 512, M = ML + MC, NIN = 11264, NEXT = 12288, DFF = 4096;
constexpr int NWAVES = 8, NTHR = 512;
constexpr size_t SLOT = (size_t)M * 1024 * 2;
constexpr size_t WS_WIN = 9 * SLOT;
constexpr size_t WS_WBR = WS_WIN + (size_t)NEXT * 1024 * 2;
constexpr size_t WS_WOUT = WS_WBR + 3ull * 1024 * 1024 * 2;
constexpr size_t WS_WRG = WS_WOUT + 1024ull * 1024 * 2;
constexpr size_t WS_WLR2 = WS_WRG + 4096ull * 64 * 2;
constexpr size_t WS_A2 = WS_WLR2 + (4ull * 1024 * 64 + 1024 * 160 + 1024 * 32) * 2;
constexpr size_t WS_XCTX = WS_A2 + (size_t)M * 448 * 2;
constexpr size_t WS_MOD = WS_XCTX + 512ull * 1024 * 4;
constexpr size_t WS_ROPE = WS_MOD + 2ull * 3 * 6144 * 4;
constexpr size_t WS_BSUM = WS_ROPE + 128ull * 16 * 2 * 4;
constexpr size_t WS_RN = WS_BSUM + (size_t)M * 16 * 4;
constexpr size_t WS_SP8 = WS_RN + (size_t)M * 16 * 4;
constexpr size_t WS_BAR = WS_SP8 + 2048 * 4;
constexpr size_t WS_BSB = WS_BAR + 16384;
constexpr size_t WS_END = WS_BSB + (size_t)M * 16 * 4;
constexpr size_t LR2_ZF = 0, LR2_ZB = 1024 * 64, LR2_AF = 2 * 1024 * 64, LR2_AB = 3 * 1024 * 64, LR2_G = 4 * 1024 * 64, LR2_V = 4 * 1024 * 64 + 1024 * 160;
constexpr int LDS_BYTES = 131072 + 4096;

__device__ __forceinline__ unsigned f2bf(float f) { unsigned r; asm("v_cvt_pk_bf16_f32 %0, %1, %1" : "=v"(r) : "v"(f)); return r & 0xffffu; }
__device__ __forceinline__ unsigned pk2(float lo, float hi) { unsigned r; asm("v_cvt_pk_bf16_f32 %0, %1, %2" : "=v"(r) : "v"(lo), "v"(hi)); return r; }
__device__ __forceinline__ float bf2f(unsigned b) { return __builtin_bit_cast(float, b << 16); }
__device__ __forceinline__ void st_bf4(bf16* p, f32x4 v) { u32x2 w; w.x = pk2(v[0], v[1]); w.y = pk2(v[2], v[3]); *(u32x2*)p = w; }
__device__ __forceinline__ f32x4 ld_bf4(const bf16* p) { u32x2 w = *(const u32x2*)p; f32x4 v; v[0] = bf2f(w.x & 0xffffu); v[1] = bf2f(w.x >> 16); v[2] = bf2f(w.y & 0xffffu); v[3] = bf2f(w.y >> 16); return v; }
__device__ __forceinline__ void st_h4(f16* p, f32x4 v) { f16x4 h; h[0] = (f16)v[0]; h[1] = (f16)v[1]; h[2] = (f16)v[2]; h[3] = (f16)v[3]; *(f16x4*)p = h; }
__device__ __forceinline__ f32x4 ld_h4(const f16* p) { f16x4 h = *(const f16x4*)p; f32x4 v; v[0] = (float)h[0]; v[1] = (float)h[1]; v[2] = (float)h[2]; v[3] = (float)h[3]; return v; }
__device__ __forceinline__ float sigmoidf_(float x) { return __builtin_amdgcn_rcpf(1.f + __expf(-x)); }
template <int CTRL> __device__ __forceinline__ float dppf(float x) { return __builtin_bit_cast(float, __builtin_amdgcn_update_dpp(0, __builtin_bit_cast(int, x), CTRL, 0xf, 0xf, true)); }
__device__ __forceinline__ float quadsum(float x) { x += dppf<0xB1>(x); x += dppf<0x4E>(x); return x; }
__device__ __forceinline__ float allred16(float x) { x += dppf<0xB1>(x); x += dppf<0x4E>(x); x += dppf<0x141>(x); x += dppf<0x140>(x); return x; }
__device__ __forceinline__ float shx(float v, int mask, int lane) { return __builtin_bit_cast(float, __builtin_amdgcn_ds_bpermute((lane ^ mask) << 2, __builtin_bit_cast(int, v))); }
__device__ __forceinline__ void swap16(float x, float& a, float& b) { a = x; b = x; asm volatile("s_nop 1\n\tv_permlane16_swap_b32 %0, %1\n\ts_nop 1" : "+v"(a), "+v"(b)); }
__device__ __forceinline__ void swap32(float x, float& a, float& b) { a = x; b = x; asm volatile("s_nop 1\n\tv_permlane32_swap_b32 %0, %1\n\ts_nop 1" : "+v"(a), "+v"(b)); }
__device__ __forceinline__ float sum_fq(float x) { float a, b; swap16(x, a, b); x = a + b; swap32(x, a, b); return a + b; }
__device__ __forceinline__ float max_fq(float x) { float a, b; swap16(x, a, b); x = fmaxf(a, b); swap32(x, a, b); return fmaxf(a, b); }
__device__ __forceinline__ float wave_sum(float v, int lane) {
    v = allred16(v); return sum_fq(v);
}
__device__ __forceinline__ void seq_of(int m, int& s0, int& len, int& pos) {
    if (m < ML) { s0 = m & ~(SEQ - 1); len = SEQ; pos = m & (SEQ - 1); }
    else { s0 = ML + ((m - ML) & ~(CTXL - 1)); len = CTXL; pos = (m - ML) & (CTXL - 1); }
}
namespace pg8 {
#define PG8_LAS __attribute__((address_space(3)))
typedef unsigned short bf16_t;
typedef short bf16x8 __attribute__((ext_vector_type(8)));
typedef float f32x4 __attribute__((ext_vector_type(4)));
typedef unsigned u32x4 __attribute__((ext_vector_type(4)));
constexpr int BM = 256, BK = 64, HALF = 128, HTB = HALF * BK * 2  , STAGE_BYTES = 8 * HTB, NXCD = 8, WGM = 8;

__host__ __device__ __forceinline__ int lds_byte(int r, int c) { const int st = (r >> 4) * 2 + (c >> 5), rr = r & 15, cc = c & 31, ob = rr * 64 + cc * 2; return st * 1024 + (ob ^ (((ob >> 9) & 1) << 5)); }
__host__ __device__ __forceinline__ void stage_rc(int b, int& R, int& C) { const int st = b / 1024, sb = b % 1024, swz = sb ^ (((sb >> 9) & 1) << 5); R = (st >> 1) * 16 + swz / 64; C = (st & 1) * 32 + (swz % 64) / 2; }
__host__ __device__ __forceinline__ int perm32(int rho) { const int n = rho >> 4, i = rho & 15; return 8 * (i >> 2) + 4 * n + (i & 3); }

struct Unit { int pm, pn; };
struct Gemm { const bf16_t* A; const bf16_t* Bt; int M, N, K; };

struct StaticOrder {
    int nM, nN, nwg, G, c;
    __host__ __device__ void init(int M, int N, int G_, int c_) { nM = M / BM; nN = N / BM; nwg = nM * nN; G = G_; c = c_; }
    __host__ __device__ bool next(int i, Unit& u) const {
        const long L = (long)i * G + c; if (L >= nwg) return false;
        int wgid = (int)L; { const int q = nwg / NXCD, r = nwg % NXCD, xcd = wgid % NXCD, off = wgid / NXCD; wgid = (xcd < r ? xcd * (q + 1) : r * (q + 1) + (xcd - r) * q) + off; }
        const int nig = WGM * nN, gid = wgid / nig, fm = gid * WGM, gsz = (nM - fm) < WGM ? (nM - fm) : WGM;
        u.pm = fm + ((wgid % nig) % gsz); u.pn = (wgid % nig) / gsz; return true;
    }
    __device__ __forceinline__ void a_ready(const Unit&) const {}
    __device__ __forceinline__ void done(const Unit&) const {}
};
template <class Epi, class Sched, bool ALIGN_EPI = false, bool SP2 = false>
__device__ __forceinline__ void gemm_phase(PG8_LAS unsigned char* lds, const Gemm g, const Sched& S, const Epi& E) {
    int tid_ = threadIdx.x; asm volatile("" : "+v"(tid_)); const int tid = tid_, wid = __builtin_amdgcn_readfirstlane(tid >> 6), lane = tid & 63, wr = wid >> 2, wc = wid & 3, fr = lane & 15, fq = lane >> 4;
    const int K = g.K, nt = K / BK;
    unsigned voffA[2], voffB[2];
#pragma unroll
    for (int i = 0; i < 2; ++i) { int R, C; stage_rc(tid * 16 + i * 8192, R, C); const int Rb = Epi::PERM ? ((R & ~31) + perm32(R & 31)) : R;
        voffA[i] = (unsigned)(R * K + C) * 2u; voffB[i] = (unsigned)(Rb * K + C) * 2u; }
    const size_t kstep = (size_t)(BK * 2);
    const size_t hstep = (size_t)HALF * K * 2;
    const size_t tstep = 2 * hstep;
    const unsigned ldsw = (unsigned)wid * 1024u;
    const int aoff = lds_byte(wr * 64 + fr, fq * 8), boff = lds_byte(wc * 32 + fr, fq * 8);
#define PG8_SA(b, h) (((b) * 2 + (h)) * HTB)
#define PG8_SB(b, h) ((4 + (b) * 2 + (h)) * HTB)
#define PG8_STAGE(bufoff, gbase, voff) do { _Pragma("unroll") for (int _i = 0; _i < 2; ++_i) \
        __builtin_amdgcn_global_load_lds((const unsigned*)((const char*)(gbase) + (voff)[_i]), (PG8_LAS unsigned*)(lds + (bufoff) + ldsw + _i * 8192), 16, 0, 0); } while (0)
#define PG8_LDA(dst, b, h) do { _Pragma("unroll") for (int m = 0; m < 4; ++m) _Pragma("unroll") for (int k = 0; k < 2; ++k) dst[m][k] = *(const PG8_LAS bf16x8*)(lds + PG8_SA(b, h) + aoff + m * 2048 + k * 1024); } while (0)
#define PG8_LDB(dst, b, h) do { _Pragma("unroll") for (int n = 0; n < 2; ++n) _Pragma("unroll") for (int k = 0; k < 2; ++k) dst[n][k] = *(const PG8_LAS bf16x8*)(lds + PG8_SB(b, h) + boff + n * 2048 + k * 1024); } while (0)
#define PG8_MMA(ai, bj, At, Bt) do { __builtin_amdgcn_s_setprio(1); _Pragma("unroll") for (int m = 0; m < 4; ++m) _Pragma("unroll") for (int n = 0; n < 2; ++n) _Pragma("unroll") for (int k = 0; k < 2; ++k) \
        acc[ai][bj][m][n] = __builtin_amdgcn_mfma_f32_16x16x32_bf16(Bt[n][k], At[m][k], acc[ai][bj][m][n], 0, 0, 0); __builtin_amdgcn_s_setprio(0); } while (0)
#define PG8_WAIT_V(n) asm volatile("s_waitcnt vmcnt(" #n ")" ::: "memory")
#define PG8_WAIT_L(n) asm volatile("s_waitcnt lgkmcnt(" #n ")" ::: "memory")
#define PG8_BAR __builtin_amdgcn_s_barrier()
#define PG8_SCHED __builtin_amdgcn_sched_barrier(0)
    Unit cur, nxt; int ui = 0;
    if (!S.next(0, cur)) return;
    f32x4 acc[2][2][4][2];
#pragma unroll
    for (int a = 0; a < 2; ++a)
#pragma unroll
        for (int b = 0; b < 2; ++b)
#pragma unroll
            for (int m = 0; m < 4; ++m)
#pragma unroll
                for (int n = 0; n < 2; ++n) acc[a][b][m][n] = (f32x4){0.f, 0.f, 0.f, 0.f};
    bf16x8 At[4][2], B0[2][2], B1[2][2];
    const char* cA = (const char*)g.A + (size_t)cur.pm * tstep; const char* cB = (const char*)g.Bt + (size_t)cur.pn * tstep;
    S.a_ready(cur);
    if constexpr (SP2) {
        PG8_STAGE(PG8_SB(0, 0), cB, voffB); PG8_STAGE(PG8_SB(0, 1), cB + hstep, voffB); PG8_STAGE(PG8_SA(0, 0), cA, voffA); PG8_STAGE(PG8_SA(0, 1), cA + hstep, voffA);
        if (wr == 1) PG8_BAR;
        PG8_WAIT_V(2); PG8_BAR;
        PG8_STAGE(PG8_SB(1, 0), cB + kstep, voffB); PG8_STAGE(PG8_SA(1, 0), cA + kstep, voffA); PG8_STAGE(PG8_SB(1, 1), cB + hstep + kstep, voffB);
        PG8_WAIT_V(6); PG8_BAR;
    } else {
        PG8_STAGE(PG8_SB(0, 0), cB, voffB); PG8_STAGE(PG8_SA(0, 0), cA, voffA); PG8_STAGE(PG8_SB(0, 1), cB + hstep, voffB); PG8_STAGE(PG8_SA(0, 1), cA + hstep, voffA);
        if (wr == 1) PG8_BAR;
        PG8_WAIT_V(4); PG8_BAR;
        PG8_STAGE(PG8_SB(1, 0), cB + kstep, voffB); PG8_STAGE(PG8_SA(1, 0), cA + kstep, voffA); PG8_STAGE(PG8_SB(1, 1), cB + hstep + kstep, voffB);
        PG8_WAIT_V(6); PG8_BAR;
    }
    for (;;) {
        const bool has_next = S.next(ui + 1, nxt);
        const char* nA = has_next ? (const char*)g.A + (size_t)nxt.pm * tstep : cA; const char* nB = has_next ? (const char*)g.Bt + (size_t)nxt.pn * tstep : cB;
        for (int t = 0; t < nt; t += 2) {
            const bool last = (t == nt - 2);
            const char* a1 = cA + (size_t)(t + 1) * kstep;
            const char* a2 = last ? nA : cA + (size_t)(t + 2) * kstep; const char* b2 = last ? nB : cB + (size_t)(t + 2) * kstep;
            const char* a3 = a2 + kstep; const char* b3 = b2 + kstep;
            if (last && has_next) S.a_ready(nxt);
            if constexpr (SP2) {
            PG8_LDB(B0, 0, 0); PG8_LDB(B1, 0, 1); PG8_SCHED; PG8_LDA(At, 0, 0); PG8_STAGE(PG8_SA(1, 1), a1 + hstep, voffA);
            PG8_WAIT_V(8); PG8_WAIT_L(0); PG8_BAR; PG8_MMA(0, 0, At, B0); PG8_MMA(0, 1, At, B1); PG8_BAR; PG8_SCHED;
            PG8_LDA(At, 0, 1); PG8_STAGE(PG8_SB(0, 0), b2, voffB); PG8_STAGE(PG8_SB(0, 1), b2 + hstep, voffB); PG8_STAGE(PG8_SA(0, 0), a2, voffA);
            PG8_WAIT_V(8); PG8_WAIT_L(0); PG8_BAR; PG8_MMA(1, 0, At, B0); PG8_MMA(1, 1, At, B1); PG8_BAR; PG8_SCHED;
            PG8_LDB(B0, 1, 0); PG8_LDB(B1, 1, 1); PG8_SCHED; PG8_LDA(At, 1, 0); PG8_STAGE(PG8_SA(0, 1), a2 + hstep, voffA);
            PG8_WAIT_V(8); PG8_WAIT_L(0); PG8_BAR; PG8_MMA(0, 0, At, B0); PG8_MMA(0, 1, At, B1); PG8_BAR; PG8_SCHED;
            PG8_LDA(At, 1, 1); PG8_STAGE(PG8_SB(1, 0), b3, voffB); PG8_STAGE(PG8_SB(1, 1), b3 + hstep, voffB); PG8_STAGE(PG8_SA(1, 0), a3, voffA);
            PG8_WAIT_V(8); PG8_WAIT_L(0); PG8_BAR; PG8_MMA(1, 0, At, B0); PG8_MMA(1, 1, At, B1); PG8_BAR; PG8_SCHED;
            } else {
            PG8_LDB(B0, 0, 0); PG8_SCHED; PG8_LDA(At, 0, 0); PG8_STAGE(PG8_SA(1, 1), a1 + hstep, voffA);
            PG8_WAIT_L(8); PG8_BAR; PG8_WAIT_L(0); PG8_MMA(0, 0, At, B0); PG8_BAR; PG8_SCHED;
            PG8_LDB(B1, 0, 1); PG8_STAGE(PG8_SB(0, 0), b2, voffB);
            PG8_BAR; PG8_WAIT_L(0); PG8_MMA(0, 1, At, B1); PG8_BAR;
            PG8_LDA(At, 0, 1); PG8_STAGE(PG8_SA(0, 0), a2, voffA);
            PG8_BAR; PG8_WAIT_L(0); PG8_MMA(1, 0, At, B0); PG8_BAR; PG8_SCHED;
            PG8_STAGE(PG8_SB(0, 1), b2 + hstep, voffB);
            PG8_WAIT_V(6); PG8_BAR; PG8_MMA(1, 1, At, B1); PG8_BAR;
            PG8_LDB(B0, 1, 0); PG8_SCHED; PG8_LDA(At, 1, 0); PG8_STAGE(PG8_SA(0, 1), a2 + hstep, voffA);
            PG8_WAIT_L(8); PG8_BAR; PG8_WAIT_L(0); PG8_MMA(0, 0, At, B0); PG8_BAR; PG8_SCHED;
            PG8_LDB(B1, 1, 1); PG8_STAGE(PG8_SB(1, 0), b3, voffB);
            PG8_BAR; PG8_WAIT_L(0); PG8_MMA(0, 1, At, B1); PG8_BAR;
            PG8_LDA(At, 1, 1); PG8_STAGE(PG8_SA(1, 0), a3, voffA);
            PG8_BAR; PG8_WAIT_L(0); PG8_MMA(1, 0, At, B0); PG8_BAR; PG8_SCHED;
            PG8_STAGE(PG8_SB(1, 1), b3 + hstep, voffB);
            PG8_WAIT_V(6); PG8_BAR; PG8_MMA(1, 1, At, B1); PG8_BAR;
            }
        }
        if constexpr (ALIGN_EPI) { if (wr == 0) PG8_BAR; }
        if constexpr (!Epi::AFTER_DRAIN) { E(acc, cur, wr, wc, fr, fq); S.done(cur); }
        if (!has_next) break;
#pragma unroll
        for (int a = 0; a < 2; ++a)
#pragma unroll
            for (int b = 0; b < 2; ++b)
#pragma unroll
                for (int m = 0; m < 4; ++m)
#pragma unroll
                    for (int n = 0; n < 2; ++n) acc[a][b][m][n] = (f32x4){0.f, 0.f, 0.f, 0.f};
        cur = nxt; cA = nA; cB = nB; ++ui;
        if constexpr (ALIGN_EPI) { if (wr == 1) PG8_BAR; }
    }
    PG8_WAIT_V(0);
    if constexpr (!ALIGN_EPI) { if (wr == 0) PG8_BAR; }
    PG8_BAR;
    if constexpr (Epi::AFTER_DRAIN) { E.fused(acc, cur, wr, wc, fr, fq, lds, wid, lane); S.done(cur); }
#undef PG8_SA
#undef PG8_SB
#undef PG8_STAGE
#undef PG8_LDA
#undef PG8_LDB
#undef PG8_MMA
#undef PG8_WAIT_V
#undef PG8_WAIT_L
#undef PG8_BAR
#undef PG8_SCHED
}
}

#define FI __device__ __forceinline__
struct Params { const float* in[43]; float* out; unsigned char* ws; int ph_lo, ph_hi; };
struct TI { int tid, lane, wave, gw, NGW, gtid, NT, vb; LAS unsigned char* lds; };
FI const float* ldsptr(LAS unsigned char* lds, int i) { volatile LAS unsigned* p = (volatile LAS unsigned*)(lds + 131072) + 2 * i; const unsigned lo = __builtin_amdgcn_readfirstlane(p[0]), hi = __builtin_amdgcn_readfirstlane(p[1]); return (const float*)(GAS const float*)(((unsigned long long)hi << 32) | lo); }
FI TI mk_ti(LAS unsigned char* lds) { TI T; int tid = threadIdx.x; asm volatile("" : "+v"(tid)); int bx = blockIdx.x; asm volatile("" : "+s"(bx)); int gx = gridDim.x; asm volatile("" : "+s"(gx));
    const int vb = (gx & 7) == 0 ? (bx & 7) * (gx >> 3) + (bx >> 3) : bx; T.vb = vb;
    T.tid = tid; T.lane = tid & 63; T.wave = __builtin_amdgcn_readfirstlane(tid >> 6); T.gw = vb * NWAVES + T.wave; T.NGW = gx * NWAVES; T.gtid = vb * NTHR + tid; T.NT = gx * NTHR; unsigned lo_ = (unsigned)(unsigned long long)lds; asm volatile("" : "+s"(lo_)); T.lds = (LAS unsigned char*)(unsigned long long)lo_; return T; }
#define PIN(i) ldsptr(T.lds, (i))
#define POUT ((float*)ldsptr(T.lds, 43))
#define PWS ((unsigned char*)ldsptr(T.lds, 44))

FI bf16* slotb(unsigned char* ws, int i) { return (bf16*)(ws + (size_t)i * SLOT); }
FI f16* sloth(unsigned char* ws, int i) { return (f16*)(ws + (size_t)i * SLOT); }

FI void ph_mod(const TI& T) {
    const float* c = PIN(1); const float* cctx = PIN(3); const float* w_ada = PIN(4); const float* b_ada = PIN(5);
    float* MOD = (float*)(PWS + WS_MOD);
    LAS float* red = (LAS float*)T.lds;
    for (int task = T.vb; task < 192; task += gridDim.x) {
        const int l = task / 96, n = (task % 96) * 64 + T.lane;
        float a0 = 0.f, a1 = 0.f, a2 = 0.f;
        const float* wp = w_ada + ((size_t)l * 1024 + T.wave * 128) * 6144 + n;
#pragma unroll 16
        for (int kk = 0; kk < 128; ++kk) {
            const int k = T.wave * 128 + kk;
            const float wv = __builtin_nontemporal_load(wp + (size_t)kk * 6144);
            const float c0 = c[k], c1 = c[1024 + k], c2 = cctx[k];
            a0 += c0 * sigmoidf_(c0) * wv; a1 += c1 * sigmoidf_(c1) * wv; a2 += c2 * sigmoidf_(c2) * wv;
        }
        red[(T.wave * 3 + 0) * 64 + T.lane] = a0; red[(T.wave * 3 + 1) * 64 + T.lane] = a1; red[(T.wave * 3 + 2) * 64 + T.lane] = a2;
        __syncthreads();
        if (T.wave == 0) {
#pragma unroll
            for (int s = 0; s < 3; ++s) { float t = 0.f;
#pragma unroll
                for (int w = 0; w < 8; ++w) t += red[(w * 3 + s) * 64 + T.lane];
                MOD[((size_t)l * 3 + s) * 6144 + n] = t + b_ada[l * 6144 + n]; }
        }
        __syncthreads();
    }
    float* tab = (float*)(PWS + WS_ROPE);
    for (int i = T.gtid; i < 2048; i += T.NT) { const int pos = i >> 4, f = i & 15; const float invf = powf(10000.f, -(float)f / 16.f); const float ang = (float)pos * invf; tab[2 * i] = cosf(ang); tab[2 * i + 1] = sinf(ang); }
}

template <class SRC>
FI void transpose_item(const SRC& src, int K, bf16* WT, int k0, int n0, LAS float* scr, int lane) {
    float tv[32];
#pragma unroll
    for (int i = 0; i < 32; ++i) tv[i] = src(k0 + 2 * i + (lane >> 5), n0 + (lane & 31));
#pragma unroll
    for (int i = 0; i < 32; ++i) scr[(2 * i + (lane >> 5)) * 33 + (lane & 31)] = tv[i];
    LDS_WAIT(); asm volatile("" ::: "memory");
    const int c = lane & 7;
#pragma unroll
    for (int j = 0; j < 4; ++j) { const int n = (lane >> 3) + 8 * j; const LAS float* s = scr + (8 * c) * 33 + n;
        u32x4 o; o.x = pk2(s[0 * 33], s[1 * 33]); o.y = pk2(s[2 * 33], s[3 * 33]); o.z = pk2(s[4 * 33], s[5 * 33]); o.w = pk2(s[6 * 33], s[7 * 33]);
        *(u32x4*)(WT + (size_t)(n0 + n) * K + k0 + 8 * c) = o; }
    LDS_WAIT(); asm volatile("" ::: "memory");
}
struct SrcPlain { const float* W; int N; FI float operator()(int k, int n) const { return __builtin_nontemporal_load(W + (size_t)k * N + n); } };
struct SrcWin { const float *w_in, *w1, *a1, *g1, *v1, *mu_h, *mu_v; int layer;
    FI float operator()(int k, int n) const {
        if (n < 8192) return __builtin_nontemporal_load(w_in + (size_t)k * NIN + n);
        if (n >= 9216) return __builtin_nontemporal_load(w_in + (size_t)k * NIN + (n - 1024));
        const int j = n - 8192; if (j >= 896) return 0.f;
        const int part = j >= 448 ? 1 : 0; const int jj = part ? j - 448 : j;
        float w, mu;
        if (jj < 128) { const int d = jj >> 6, cc = jj & 63; w = w1[((size_t)d * 1024 + k) * 64 + cc]; mu = mu_h[k]; }
        else if (jj < 256) { const int d = (jj - 128) >> 6, cc = jj & 63; w = a1[((size_t)d * 1024 + k) * 64 + cc]; mu = mu_h[1024 + k]; }
        else if (jj < 416) { w = g1[(size_t)k * 160 + (jj - 256)]; mu = mu_h[2048 + k]; }
        else { if (layer == 0) return 0.f; w = v1[(size_t)k * 32 + (jj - 416)]; mu = mu_v[k]; }
        return part ? w * mu : w * (1.f - mu);
    } };

FI void ph_weights_mixer(const TI& T, int l) {
    LAS float* scr = (LAS float*)(T.lds + T.wave * 16384);
    SrcWin sw; sw.w_in = PIN(8) + (size_t)l * 1024 * NIN; sw.w1 = PIN(20) + (size_t)l * 2 * 1024 * 64; sw.a1 = PIN(23) + (size_t)l * 2 * 1024 * 64;
    sw.g1 = PIN(25) + (size_t)l * 1024 * 160; sw.v1 = PIN(33) + (size_t)(l > 0 ? l - 1 : 0) * 1024 * 32; sw.mu_h = PIN(18) + (size_t)l * 3 * 1024; sw.mu_v = PIN(35) + (size_t)(l > 0 ? l - 1 : 0) * 1024; sw.layer = l;
    bf16* WIN = (bf16*)(PWS + WS_WIN);
    constexpr int I_IN = 16 * 384, I_SQ = 16 * 32;
    for (int it = T.gw; it < I_IN + 4 * I_SQ; it += T.NGW) {
        int r = it;
        if (r < I_IN) { transpose_item(sw, 1024, WIN, (r / 384) * 64, (r % 384) * 32, scr, T.lane); continue; }
        r -= I_IN; const int which = r / I_SQ; r %= I_SQ;
        SrcPlain sp; sp.N = 1024; sp.W = PIN(36 + which) + (size_t)l * 1024 * 1024;
        bf16* WT = which < 3 ? (bf16*)(PWS + WS_WBR) + (size_t)which * 1024 * 1024 : (bf16*)(PWS + WS_WOUT);
        transpose_item(sp, 1024, WT, (r / 32) * 64, (r % 32) * 32, scr, T.lane);
    }
    bf16* WRG = (bf16*)(PWS + WS_WRG);
    for (int i = T.gtid; i < 4096 * 64; i += T.NT) { const int n = i >> 6, d = i & 63, dir = n >> 11, blk = (n >> 7) & 15, hb = (n >> 6) & 1, which = (n >> 5) & 1, e = hb * 32 + (n & 31);
        const float* W = (which ? PIN(14) : PIN(12)) + ((((size_t)l * 2 + dir) * 16 + blk) * 64 + d) * 64 + e; WRG[i] = (bf16)f2bf(*W); }
    for (int i = T.gtid; i < 2048; i += T.NT) ((float*)(PWS + WS_SP8))[i] = 8.f * log1pf(__expf(-PIN(16)[(size_t)l * 2048 + i]));
    bf16* L2 = (bf16*)(PWS + WS_WLR2);
    for (int i = T.gtid; i < 4 * 1024 * 64; i += T.NT) { const int g = i >> 16, n = (i >> 6) & 1023, k = i & 63; const int dir = g & 1;
        const float* W = (g < 2 ? PIN(21) : PIN(24)) + (((size_t)l * 2 + dir) * 64 + k) * 1024 + n; L2[i] = (bf16)f2bf(*W); }
    for (int i = T.gtid; i < 1024 * 160; i += T.NT) { const int n = i / 160, k = i % 160; L2[LR2_G + i] = (bf16)f2bf(PIN(26)[((size_t)l * 160 + k) * 1024 + n]); }
    if (l > 0) for (int i = T.gtid; i < 1024 * 32; i += T.NT) { const int n = i >> 5, k = i & 31; L2[LR2_V + i] = (bf16)f2bf(PIN(34)[((size_t)(l - 1) * 32 + k) * 1024 + n]); }
}
FI void ph_weights_mlp(const TI& T, int l) {
    LAS float* scr = (LAS float*)(T.lds + T.wave * 16384);
    bf16* W1T = (bf16*)(PWS + WS_WIN); bf16* W2T = W1T + (size_t)4096 * 1024;
    for (int it = T.gw; it < 4096; it += T.NGW) {
        if (it < 2048) { SrcPlain sp; sp.N = 4096; sp.W = PIN(40) + (size_t)l * 1024 * 4096; transpose_item(sp, 1024, W1T, (it / 128) * 64, (it % 128) * 32, scr, T.lane); }
        else { const int r = it - 2048; SrcPlain sp; sp.N = 1024; sp.W = PIN(41) + (size_t)l * 4096 * 1024; transpose_item(sp, 4096, W2T, (r / 32) * 64, (r % 32) * 32, scr, T.lane); }
    }
}

FI void ph_norm(const TI& T, int l, int which, bf16* __restrict__ H) {
    const float* __restrict__ gam = PIN(which ? 7 : 6) + l * 1024;
    const float* MODl = (const float*)(PWS + WS_MOD) + (size_t)l * 3 * 6144;
    const bool first = (l == 0 && which == 0);
#pragma unroll 2
    for (int m = T.gw; m < M; m += T.NGW) {
        const float* __restrict__ xr; int s;
        if (m < ML) { xr = (first ? PIN(0) : (const float*)POUT) + (size_t)m * 1024; s = m >> 13; }
        else { xr = (first ? PIN(2) : (const float*)(PWS + WS_XCTX)) + (size_t)(m - ML) * 1024; s = 2; }
        const float* sh = MODl + s * 6144 + (which ? 3072 : 0); const float* sc = sh + 1024;
        f32x4 v[4]; float ss = 0.f;
#pragma unroll
        for (int j = 0; j < 4; ++j) { v[j] = *(const f32x4*)(xr + (64 * j + T.lane) * 4); ss += (v[j][0] * v[j][0] + v[j][1] * v[j][1]) + (v[j][2] * v[j][2] + v[j][3] * v[j][3]); }
        const float rstd = rsqrtf(wave_sum(ss, T.lane) * (1.f / 1024.f) + 1e-6f);
#pragma unroll
        for (int j = 0; j < 4; ++j) { const int cc = (64 * j + T.lane) * 4; const f32x4 g4 = *(const f32x4*)(gam + cc), sc4 = *(const f32x4*)(sc + cc), sh4 = *(const f32x4*)(sh + cc);
            const f32x4 o = (v[j] * rstd * g4) * (1.f + sc4) + sh4; st_bf4(H + (size_t)m * 1024 + cc, o); }
    }
}
FI void ph_final(const TI& T) {
    const float* gam = PIN(42);
    for (int m = T.gw; m < ML; m += T.NGW) {
        float* xr = POUT + (size_t)m * 1024; f32x4 v[4]; float ss = 0.f;
#pragma unroll
        for (int j = 0; j < 4; ++j) { v[j] = *(const f32x4*)(xr + (64 * j + T.lane) * 4); ss += (v[j][0] * v[j][0] + v[j][1] * v[j][1]) + (v[j][2] * v[j][2] + v[j][3] * v[j][3]); }
        const float rstd = rsqrtf(wave_sum(ss, T.lane) * (1.f / 1024.f) + 1e-6f);
#pragma unroll
        for (int j = 0; j < 4; ++j) { const int cc = (64 * j + T.lane) * 4; *(f32x4*)(xr + cc) = v[j] * rstd * *(const f32x4*)(gam + cc); }
    }
}

template <class F> struct Epi {
    static constexpr bool PERM = false, AFTER_DRAIN = false;
    F f;
    FI void operator()(const pg8::f32x4 (&acc)[2][2][4][2], const pg8::Unit& u, int wr, int wc, int fr, int fq) const {
#pragma unroll
        for (int ai = 0; ai < 2; ++ai)
#pragma unroll
            for (int m = 0; m < 4; ++m) { const int row = u.pm * 256 + ai * 128 + wr * 64 + m * 16 + fr;
#pragma unroll
                for (int bj = 0; bj < 2; ++bj) { const int col = u.pn * 256 + bj * 128 + wc * 32 + 4 * fq; f(row, col, acc[ai][bj][m][0], acc[ai][bj][m][1]); }
                asm volatile("" ::: "memory"); }
    }
};
template <class F> FI void run_gemm(const TI& T, const bf16* A, const bf16* Bt, int N, int K, const F& f) {
    pg8::Gemm g{A, Bt, M, N, K}; pg8::StaticOrder S; S.init(M, N, (int)gridDim.x, (int)blockIdx.x);
    Epi<F> E{f};
    pg8::gemm_phase<Epi<F>, pg8::StaticOrder, true, true>((PG8_LAS unsigned char*)T.lds, g, S, E);
}
struct FRw { unsigned char* ws;
    FI void operator()(int row, int col, f32x4 v0, f32x4 v1) const {
        f16* dst = sloth(ws, 1 + (col >> 10)) + (size_t)row * 1024 + (col & 1023); st_h4(dst, v0); st_h4(dst + 16, v1); } };
struct FNat { unsigned char* ws; const float* rope;
    FI void operator()(int row, int col, f32x4 v0, f32x4 v1) const {
        const int sel = col >> 10, cc = col & 1023;
        if (sel < 2) {
            if (row < ML) {
                const int t = row & (SEQ - 1); const int pos = ((cc >> 5) & 1) ? (t & 63) : (t >> 6);
                const float* tp = rope + ((size_t)pos * 16 + (cc & 15)) * 2;
                const f32x4 t0 = *(const f32x4*)tp, t1 = *(const f32x4*)(tp + 4);
                const f32x4 cs = {t0[0], t0[2], t1[0], t1[2]}, sn = {t0[1], t0[3], t1[1], t1[3]};
                const f32x4 o0 = v0 * cs - v1 * sn, o1 = v0 * sn + v1 * cs; v0 = o0; v1 = o1;
            }
            bf16* dst = slotb(ws, 1 + sel) + (size_t)row * 1024 + cc; st_bf4(dst, v0); st_bf4(dst + 16, v1);
        } else {
            const int h = (cc >> 6), d = cc & 63; bf16* vt = slotb(ws, 3); size_t base, stride;
            if (row < ML) { const int b = row >> 13, t = row & (SEQ - 1); stride = SEQ; base = ((size_t)(b * 16 + h) * 64 + d) * SEQ + t; }
            else { const int rr = row - ML, b = rr >> 8, j = rr & 255; stride = CTXL; base = (size_t)ML * 1024 + ((size_t)(b * 16 + h) * 64 + d) * CTXL + j; }
#pragma unroll
            for (int i = 0; i < 4; ++i) { vt[base + i * stride] = (bf16)f2bf(v0[i]); vt[base + (16 + i) * stride] = (bf16)f2bf(v1[i]); }
        }
    } };
FI f32x4 gelu4(f32x4 x) { f32x4 o;
#pragma unroll
    for (int i = 0; i < 4; ++i) { const float u = 0.7978845608f * (x[i] + 0.044715f * x[i] * x[i] * x[i]); o[i] = x[i] * sigmoidf_(2.f * u); } return o; }
FI f32x4 sig4(f32x4 x) { f32x4 o;
#pragma unroll
    for (int i = 0; i < 4; ++i) o[i] = sigmoidf_(x[i]); return o; }
struct FLru { unsigned char* ws;
    FI void operator()(int row, int col, f32x4 v0, f32x4 v1) const {
        const int sel = col >> 10, cc = col & 1023; bf16* dst = slotb(ws, 2 + sel) + (size_t)row * 1024 + cc;
        if (sel) { v0 = gelu4(v0); v1 = gelu4(v1); } st_bf4(dst, v0); st_bf4(dst + 16, v1); } };
struct FGate { unsigned char* ws;
    FI void operator()(int row, int col, f32x4 v0, f32x4 v1) const {
        const int sel = col >> 10, cc = col & 1023; bf16* dst = slotb(ws, sel == 0 ? 2 : (sel == 1 ? 3 : 6)) + (size_t)row * 1024 + cc;
        st_bf4(dst, sig4(v0)); st_bf4(dst + 16, sig4(v1)); } };
template <int KB> struct FBr { const bf16* gate; bf16* mixed;
    FI void operator()(int row, int col, f32x4 v0, f32x4 v1) const {
        const size_t o = (size_t)row * 1024 + col; f32x4 r0 = ld_bf4(gate + o) * v0, r1 = ld_bf4(gate + o + 16) * v1;
        if (KB > 0) { r0 += ld_bf4(mixed + o); r1 += ld_bf4(mixed + o + 16); }
        st_bf4(mixed + o, r0); st_bf4(mixed + o + 16, r1); } };
struct FRes { const float* xl_old; float* xl_new; const float* xc_old; float* xc_new; const float* gt; bool ctx_store;
    FI void operator()(int row, int col, f32x4 v0, f32x4 v1) const {
        const float* xo; float* xn; const float* g;
        if (row < ML) { const size_t o = (size_t)row * 1024 + col; xo = xl_old + o; xn = xl_new + o; g = gt + (row >> 13) * 6144 + col; }
        else { if (!ctx_store) return; const size_t o = (size_t)(row - ML) * 1024 + col; xo = xc_old + o; xn = xc_new + o; g = gt + 2 * 6144 + col; }
        *(f32x4*)xn = *(const f32x4*)xo + *(const f32x4*)g * v0; *(f32x4*)(xn + 16) = *(const f32x4*)(xo + 16) + *(const f32x4*)(g + 16) * v1; } };
struct FFf1 { bf16* hid;
    FI void operator()(int row, int col, f32x4 v0, f32x4 v1) const {
        bf16* dst = hid + (size_t)row * 4096 + col;
#pragma unroll
        for (int i = 0; i < 4; ++i) { const float a = fmaxf(v0[i], 0.f), b = fmaxf(v1[i], 0.f); v0[i] = a * a; v1[i] = b * b; }
        st_bf4(dst, v0); st_bf4(dst + 16, v1); } };

template <int K, int MT, class F>
FI void sgemm_t(const TI& T, const bf16* __restrict__ A, int lda, int acol0, int blkmod, const bf16* __restrict__ Bt, int ncoltiles, const F& f, int blkshift = 0) {
    const int fr = T.lane & 15, fq = T.lane >> 4;
    const int nitems = (M / (16 * MT)) * ncoltiles;
    constexpr int KS = K / 32; constexpr bool PF = (K * MT <= 320);
    bf16x8 af[PF ? KS : 1][MT], bfr[PF ? KS : 1][4];
#define SG_LOAD(it_, ks_, slot_) { const int rt_ = (it_) / ncoltiles, ct_ = (it_) % ncoltiles; const int acol_ = acol0 + (blkmod ? ((ct_ >> blkshift) % blkmod) * 64 : 0); \
        _Pragma("unroll") for (int m = 0; m < MT; ++m) af[slot_][m] = *(const bf16x8*)(A + (size_t)(rt_ * (16 * MT) + 16 * m + fr) * lda + acol_ + (ks_) * 32 + fq * 8); \
        _Pragma("unroll") for (int n = 0; n < 4; ++n) bfr[slot_][n] = *(const bf16x8*)(Bt + (size_t)(ct_ * 64 + 16 * n + fr) * K + (ks_) * 32 + fq * 8); }
    if (PF && T.gw < nitems) {
#pragma unroll
        for (int ks = 0; ks < KS; ++ks) SG_LOAD(T.gw, ks, (PF ? ks : 0));
    }
    for (int it = T.gw; it < nitems; it += T.NGW) {
        const int rt = it / ncoltiles, ct = it % ncoltiles, row0 = rt * (16 * MT);
        f32x4 acc[MT][4];
#pragma unroll
        for (int m = 0; m < MT; ++m)
#pragma unroll
            for (int n = 0; n < 4; ++n) acc[m][n] = (f32x4){0.f, 0.f, 0.f, 0.f};
#pragma unroll
        for (int ks = 0; ks < KS; ++ks) {
            if (!PF) SG_LOAD(it, ks, 0);
#pragma unroll
            for (int m = 0; m < MT; ++m)
#pragma unroll
                for (int n = 0; n < 4; ++n) acc[m][n] = __builtin_amdgcn_mfma_f32_16x16x32_bf16(bfr[PF ? ks : 0][n], af[PF ? ks : 0][m], acc[m][n], 0, 0, 0);
        }
        if (PF && it + T.NGW < nitems) {
#pragma unroll
            for (int ks = 0; ks < KS; ++ks) SG_LOAD(it + T.NGW, ks, (PF ? ks : 0));
        }
#pragma unroll
        for (int m = 0; m < MT; ++m) f.row(row0 + 16 * m + fr, ct, fq, acc[m]);
        f.tile_done(rt, ct);
    }
#undef SG_LOAD
}
template <int K, class F>
FI void sgemm(const TI& T, const bf16* __restrict__ A, int lda, int acol0, int blkmod, const bf16* __restrict__ Bt, int ncoltiles, const F& f, int blkshift = 0) { sgemm_t<K, 4, F>(T, A, lda, acol0, blkmod, Bt, ncoltiles, f, blkshift); }
#define ROWWISE FI void tile_done(int, int) const {} FI void row(int r, int ct, int fq, const f32x4 (&a)[4]) const { _Pragma("unroll") for (int n = 0; n < 4; ++n) (*this)(r, ct * 64 + 16 * n + 4 * fq, a[n]); }
struct FOmw { f16* dst; const float* bias;
    ROWWISE
    FI void operator()(int row, int col, f32x4 v) const { f32x4 o;
#pragma unroll
        for (int i = 0; i < 4; ++i) { const float sg = sigmoidf_(v[i] + bias[col + i]); o[i] = 1.f - __expf(-0.60653066f * sg); }
        st_h4(dst + (size_t)row * 1024 + col, o); } };
struct FSigH { f16* dst; const float* bias;
    ROWWISE
    FI void operator()(int row, int col, f32x4 v) const { f32x4 o;
#pragma unroll
        for (int i = 0; i < 4; ++i) o[i] = sigmoidf_(v[i] + bias[col + i]);
        st_h4(dst + (size_t)row * 1024 + col, o); } };
struct FLr2All { FI void tile_done(int, int) const {} unsigned char* ws; const float* w0; const float* a0;
    FI void row(int r, int ct, int fq, const f32x4 (&a)[4]) const {
        const int which = ct >> 4, ctl = ct & 15; const bool dec = which < 2;
        f16* dst = sloth(ws, which == 0 ? 1 : (which == 1 ? 3 : (which == 2 ? 2 : 4))) + (size_t)r * 1024;
        const float* bias = (dec ? w0 : a0) + (which & 1) * 1024;
#pragma unroll
        for (int n = 0; n < 4; ++n) { const int col = ctl * 64 + 16 * n + 4 * fq; f32x4 o;
#pragma unroll
            for (int i = 0; i < 4; ++i) { const float sg = sigmoidf_(a[n][i] + bias[col + i]); o[i] = dec ? 1.f - __expf(-0.60653066f * sg) : sg; }
            st_h4(dst + col, o); }
    } };
struct FVmix { f16* V; const f16* VF; const float* bias;
    ROWWISE
    FI void operator()(int row, int col, f32x4 a) const { const size_t o = (size_t)row * 1024 + col; f32x4 g;
#pragma unroll
        for (int i = 0; i < 4; ++i) g[i] = sigmoidf_(a[i] + bias[col + i]);
        const f32x4 v = ld_h4(V + o), vf = ld_h4(VF + o); st_h4(V + o, v + (vf - v) * g); } };
struct FPlainB { bf16* dst;
    ROWWISE
    FI void operator()(int row, int col, f32x4 v) const { st_bf4(dst + (size_t)row * 1024 + col, v); } };
struct FPost { FI void tile_done(int, int) const {} const bf16* __restrict__ YF; const bf16* __restrict__ YB; const f16* __restrict__ V; bf16* __restrict__ OUT; const float* __restrict__ BS; const float* __restrict__ BS2; const float* __restrict__ lnw; const float* __restrict__ lnb; int lane;
    FI void row(int r, int ct, int fq, const f32x4 (&g)[4]) const {
        const size_t o = (size_t)r * 1024 + ct * 64 + 4 * fq; f32x4 y[4], v[4]; float s = 0.f;
#pragma unroll
        for (int n = 0; n < 4; ++n) { y[n] = ld_bf4(YF + o + 16 * n) + ld_bf4(YB + o + 16 * n); v[n] = ld_h4(V + o + 16 * n); s += (y[n][0] + y[n][1]) + (y[n][2] + y[n][3]); }
        const float bsm = BS[(size_t)r * 16 + ct] + BS2[(size_t)r * 16 + ct];
        s = sum_fq(s);
        const float mean = s * (1.f / 64.f); float vs = 0.f;
#pragma unroll
        for (int n = 0; n < 4; ++n) { y[n] -= mean; vs += (y[n][0] * y[n][0] + y[n][1] * y[n][1]) + (y[n][2] * y[n][2] + y[n][3] * y[n][3]); }
        vs = sum_fq(vs);
        const float rstd = rsqrtf(vs * (1.f / 64.f) + 64e-5f);
#pragma unroll
        for (int n = 0; n < 4; ++n) { const int cc = ct * 64 + 16 * n + 4 * fq;
            const f32x4 yn = y[n] * rstd * *(const f32x4*)(lnw + cc) + *(const f32x4*)(lnb + cc);
            st_bf4(OUT + o + 16 * n, (yn + bsm * v[n]) * g[n]); }
    } };
struct FRgAB { unsigned char* ws; const float* ba; const float* bx; const float* sp8t; const bf16* UC; int bbslot; LAS f32x2* wl; int lane;
    FI void row(int r, int ct, int fq, const f32x4 (&acc)[4]) const {
        const int dir = ct >> 5, blk = (ct >> 1) & 15, hb = ct & 1;
        f16* OM = sloth(ws, dir ? 2 : 6); f16* BB = sloth(ws, dir ? bbslot : 7);
#pragma unroll
        for (int np = 0; np < 2; ++np) {
            const int ch = blk * 64 + hb * 32 + 16 * np + 4 * fq; const size_t o = (size_t)r * 1024 + ch;
            const f32x4 gr = acc[np] + *(const f32x4*)(ba + dir * 1024 + ch), gi = acc[np + 2] + *(const f32x4*)(bx + dir * 1024 + ch), sp = *(const f32x4*)(sp8t + dir * 1024 + ch), u = ld_bf4(UC + o);
            f32x4 om, bb;
#pragma unroll
            for (int i = 0; i < 4; ++i) { const float rr = sigmoidf_(gr[i]), ii = sigmoidf_(gi[i]), la = -sp[i] * rr; om[i] = 1.f - __expf(la); bb[i] = __builtin_amdgcn_sqrtf(fmaxf(1.f - __expf(2.f * la), 0.f)) * (ii * u[i]); }
            st_h4(OM + o, om); st_h4(BB + o, bb);
#pragma unroll
            for (int i = 0; i < 4; ++i) wl[(r & 63) * 32 + ((16 * np + 4 * fq + i) ^ (r & 15))] = (f32x2){1.f - (float)(f16)om[i], (float)(f16)bb[i]};
        }
    }
    FI void tile_done(int rt, int ct) const {
        LDS_WAIT();
        const int dir = ct >> 5, blk = (ct >> 1) & 15, hb = ct & 1;
        if (lane < 32) {
            float Ap = 1.f, Bp = 0.f;
#pragma unroll 16
            for (int i = 0; i < 64; ++i) { const int rr_ = dir ? 63 - i : i; const f32x2 ab = wl[rr_ * 32 + (lane ^ (rr_ & 15))]; Ap *= ab.x; Bp = ab.x * Bp + ab.y; }
            ((f32x2*)(ws + WS_A2))[((size_t)dir * 264 + rt) * 1024 + blk * 64 + hb * 32 + lane] = (f32x2){Ap, Bp};
        }
        LDS_WAIT();
    } };

FI void ph_shiftmix(const TI& T, int l, int vslot) {
    unsigned char* ws = PWS; const float* __restrict__ mu = PIN(17) + (size_t)l * 3 * 1024;
    bf16* __restrict__ A2 = (bf16*)(ws + WS_A2); const f16* __restrict__ LR = sloth(ws, 4);
    const f16* __restrict__ s0 = sloth(ws, 1); const f16* __restrict__ s1 = sloth(ws, 2); const f16* __restrict__ s2 = sloth(ws, 3);
    f16* __restrict__ d0 = sloth(ws, 5); f16* __restrict__ d1 = sloth(ws, 6); f16* __restrict__ d2 = sloth(ws, vslot);
    const float* __restrict__ kkp = PIN(27) + l * 1024; float* __restrict__ RN = (float*)(ws + WS_RN);
#pragma unroll 4
    for (int it = T.gtid; it < M * 256; it += T.NT) {
        const int m = it >> 8, cc = (it & 255) * 4; int sq0, len, pos; seq_of(m, sq0, len, pos);
        const bool hp = pos > 0, hn = pos < len - 1; const size_t o = (size_t)m * 1024 + cc;
        const size_t op = hp ? o - 1024 : o, on = hn ? o + 1024 : o; const float fp = hp ? 0.5f : 0.f, fn = hn ? 0.5f : 0.f;
        const f32x4 c0 = ld_h4(s0 + o), p0 = ld_h4(s0 + op), n0 = ld_h4(s0 + on), c1 = ld_h4(s1 + o), p1 = ld_h4(s1 + op), n1 = ld_h4(s1 + on), c2 = ld_h4(s2 + o), p2 = ld_h4(s2 + op), n2 = ld_h4(s2 + on);
        const f32x4 m0 = *(const f32x4*)(mu + cc), m1 = *(const f32x4*)(mu + 1024 + cc), m2 = *(const f32x4*)(mu + 2048 + cc);
        const f32x4 ks = c1 + m1 * ((fp * p1 + fn * n1) - c1);
        st_h4(d0 + o, c0 + m0 * ((fp * p0 + fn * n0) - c0)); st_h4(d1 + o, ks); st_h4(d2 + o, c2 + m2 * ((fp * p2 + fn * n2) - c2));
        const f32x4 kq = ks * *(const f32x4*)(kkp + cc); float ss = (kq[0] * kq[0] + kq[1] * kq[1]) + (kq[2] * kq[2] + kq[3] * kq[3]); ss = allred16(ss);
        if ((it & 15) == 0) RN[(size_t)m * 16 + (cc >> 6)] = 1.f / fmaxf(sqrtf(ss), 1e-12f);
    }
#pragma unroll 4
    for (int it = T.gtid; it < M * 112; it += T.NT) {
        const int m = it / 112, jc = (it % 112) * 4; int sq0, len, pos; seq_of(m, sq0, len, pos);
        const bool hp = pos > 0, hn = pos < len - 1; const size_t o = (size_t)m * 1024;
        const size_t op = hp ? o - 1024 : o, on = hn ? o + 1024 : o; const float fp = hp ? 0.5f : 0.f, fn = hn ? 0.5f : 0.f;
        f32x4 u = ld_h4(LR + o + jc); const f32x4 pv = ld_h4(LR + op + 448 + jc), nx = ld_h4(LR + on + 448 + jc);
        u += fp * pv + fn * nx;
        if (jc < 128) {
#pragma unroll
            for (int i = 0; i < 4; ++i) u[i] = 2.f * sigmoidf_(2.f * u[i]) - 1.f;
        } else if (jc >= 256 && jc < 416) u = sig4(u);
        st_bf4(A2 + (size_t)m * 448 + jc, u);
    }
}
FI void ph_rwprep(const TI& T, int l, int vslot) {
    unsigned char* ws = PWS;
    const float* __restrict__ k_k = PIN(27) + l * 1024; const float* __restrict__ k_a = PIN(28) + l * 1024; const float* __restrict__ r_k = PIN(29) + l * 1024;
    float* __restrict__ BS = (float*)(ws + WS_BSUM); float* __restrict__ RN = (float*)(ws + WS_RN);
    const f16* __restrict__ K = sloth(ws, 6); const f16* __restrict__ R = sloth(ws, 5); const f16* __restrict__ AF = sloth(ws, 2); const f16* __restrict__ AB = sloth(ws, 4);
    f16* __restrict__ V = sloth(ws, vslot); const f16* __restrict__ VF = sloth(ws, 8); const f16* __restrict__ VG = sloth(ws, 0);
    const int c0 = T.lane * 16, head = T.lane >> 2;
#pragma unroll 2
    for (int m = T.gw; m < M; m += T.NGW) {
        const size_t o = (size_t)m * 1024 + c0; float ss = 0.f, bs = 0.f;
#pragma unroll
        for (int q = 0; q < 4; ++q) {
            const int cc = c0 + 4 * q; const size_t oo = o + 4 * q;
            const f32x4 k = ld_h4(K + oo), r = ld_h4(R + oo), af = ld_h4(AF + oo), ab = ld_h4(AB + oo);
            const f32x4 kk4 = *(const f32x4*)(k_k + cc), ka4 = *(const f32x4*)(k_a + cc), rk4 = *(const f32x4*)(r_k + cc);
            const f32x4 kq = k * kk4; ss += (kq[0] * kq[0] + kq[1] * kq[1]) + (kq[2] * kq[2] + kq[3] * kq[3]);
            const f32x4 kds = k * (2.f + (af + ab - 2.f) * ka4);
            const f32x4 t = r * kds * rk4; bs += (t[0] + t[1]) + (t[2] + t[3]);
            if (l > 0) { const f32x4 v = ld_h4(V + oo), vf = ld_h4(VF + oo), vg = ld_h4(VG + oo); st_h4(V + oo, v + (vf - v) * vg); }
        }
        ss = quadsum(ss); bs = quadsum(bs);
        if ((T.lane & 3) == 0) { RN[(size_t)m * 16 + head] = 1.f / fmaxf(sqrtf(ss), 1e-12f); BS[(size_t)m * 16 + head] = bs; }
    }
}
FI void ph_rwscan(const TI& T, int l, int vslot, int ybslot) {
    unsigned char* ws = PWS;
    constexpr int GS = 32, NG = (SEQ + CTXL) / GS, REC = 5 * 64 + 16;
    LAS float* ring = (LAS float*)T.lds;
    const float* RN = (const float*)(ws + WS_RN);
    for (int ct = T.vb; ct < 256; ct += gridDim.x) {
        const int chain = ct >> 2, rq = ct & 3, b = chain >> 5, h = (chain >> 1) & 15, dir = chain & 1, hc = h * 64;
        const int cbase = ML + b * CTXL, lbase = b * SEQ;
#define RW_ROW(s) ((s) < CTXL ? (dir ? cbase + CTXL - 1 - (s) : cbase + (s)) : (dir ? lbase + SEQ - 1 - ((s) - CTXL) : lbase + ((s) - CTXL)))
        if (T.wave >= 4) {
            const int pw = T.wave - 4, lane = T.lane;
            const f16* Rp = sloth(ws, 5) + hc + lane; const f16* Kp = sloth(ws, 6) + hc + lane; const f16* Vp = sloth(ws, vslot) + hc + rq * 16 + (lane & 15);
            const f16* Op = sloth(ws, dir ? 3 : 1) + hc + lane; const f16* Ap = sloth(ws, dir ? 4 : 2) + hc + lane;
            const float kkc = PIN(27)[l * 1024 + hc + lane], kac = PIN(28)[l * 1024 + hc + lane], rkc = PIN(29)[l * 1024 + hc + lane];
            float* __restrict__ BSd = (float*)(ws + (dir ? WS_BSB : WS_BSUM));
            f16 cr[8], ck[8], co[8], ca[8], cv[8]; float crn[8];
            f16 nr[8], nk[8], no[8], na[8], nv[8]; float nrn[8];
#define RW_LOAD(R_, K_, O_, A_, V_, N_, g_) { _Pragma("unroll") for (int u = 0; u < 8; ++u) { const int mm = RW_ROW((g_) * GS + pw * 8 + u); const size_t ro = (size_t)mm * 1024; \
                R_[u] = Rp[ro]; K_[u] = Kp[ro]; O_[u] = Op[ro]; A_[u] = Ap[ro]; V_[u] = Vp[ro]; N_[u] = RN[(size_t)mm * 16 + h]; } }
#define RW_CONV(R_, K_, O_, A_, V_, N_, buf_, g_) { _Pragma("unroll") for (int u = 0; u < 8; ++u) { LAS float* rec = ring + ((buf_) * GS + pw * 8 + u) * REC; \
                const float k = (float)K_[u], a = (float)A_[u]; const float kk = k * (kkc * N_[u]); const float kd = k * (1.f + (a - 1.f) * kac), rr = (float)R_[u]; \
                rec[lane] = kk; rec[64 + lane] = -(kk * a); rec[128 + lane] = kd; rec[192 + lane] = 1.f - (float)O_[u]; rec[256 + lane] = rr; if (lane < 16) rec[320 + lane] = (float)V_[u]; \
                if (rq == 0) { const float bs = wave_sum(rr * kd * rkc, lane); if (lane == 0) BSd[(size_t)RW_ROW((g_) * GS + pw * 8 + u) * 16 + h] = bs; } } }
            RW_LOAD(cr, ck, co, ca, cv, crn, 0);
            RW_CONV(cr, ck, co, ca, cv, crn, 0, 0);
            RW_LOAD(cr, ck, co, ca, cv, crn, 1);
            __syncthreads();
            for (int g = 0; g < NG; ++g) {
                if (g + 2 < NG) RW_LOAD(nr, nk, no, na, nv, nrn, g + 2);
                if (g + 1 < NG) RW_CONV(cr, ck, co, ca, cv, crn, (g + 1) & 1, g + 1);
#pragma unroll
                for (int u = 0; u < 8; ++u) { cr[u] = nr[u]; ck[u] = nk[u]; co[u] = no[u]; ca[u] = na[u]; cv[u] = nv[u]; crn[u] = nrn[u]; }
                __syncthreads();
            }
#undef RW_LOAD
#undef RW_CONV
        } else {
            const int vl = T.wave * 4 + (T.lane >> 4), kq = (T.lane & 15) * 4;
            GAS bf16* Yp = (GAS bf16*)(slotb(ws, dir ? ybslot : 0) + hc + rq * 16 + vl);
            const bool wr = (T.lane & 15) == 0;
            f32x4 S = {0.f, 0.f, 0.f, 0.f};
            __syncthreads();
            for (int g = 0; g < NG; ++g) {
                const LAS float* rec = ring + ((g & 1) * GS) * REC;
                const int m0 = RW_ROW(g * GS); const long ystep = dir ? -1024 : 1024;
                GAS bf16* yp = Yp + (size_t)m0 * 1024;
                f32x4 kk[3], bb[3], kd[3], w[3], r[3]; float v[3];
#define RW_LDREC(j_, s_) { const LAS float* q_ = rec + (s_) * REC; kk[j_] = *(const LAS f32x4*)(q_ + kq); bb[j_] = *(const LAS f32x4*)(q_ + 64 + kq); kd[j_] = *(const LAS f32x4*)(q_ + 128 + kq); \
                    w[j_] = *(const LAS f32x4*)(q_ + 192 + kq); r[j_] = *(const LAS f32x4*)(q_ + 256 + kq); v[j_] = q_[320 + vl]; }
                RW_LDREC(0, 0); RW_LDREC(1, 1);
                const int lb0 = T.lane & 1, lb1 = (T.lane >> 1) & 1;
                const long yoff = (long)(lb1 + 2 * lb0) * ystep;
                const bool wr4 = (T.lane & 15) < 4;
                float p[4];
#pragma unroll
                for (int si = 0; si < GS; ++si) {
                    if (si + 2 < GS) RW_LDREC((si + 2) % 3, si + 2);
                    const int j = si % 3;
                    float d = (S[0] * kk[j][0] + S[1] * kk[j][1]) + (S[2] * kk[j][2] + S[3] * kk[j][3]);
                    const f32x4 base = S * w[j] + v[j] * kd[j];
                    d = allred16(d);
                    S = base + d * bb[j];
                    p[si & 3] = (S[0] * r[j][0] + S[1] * r[j][1]) + (S[2] * r[j][2] + S[3] * r[j][3]);
                    if ((si & 3) == 3) {
                        float kA = lb0 ? p[2] : p[0], sA = lb0 ? p[0] : p[2], kB = lb0 ? p[3] : p[1], sB = lb0 ? p[1] : p[3];
                        kA += dppf<0xB1>(sA); kB += dppf<0xB1>(sB);
                        float kC = lb1 ? kB : kA, sC = lb1 ? kA : kB;
                        kC += dppf<0x4E>(sC);
                        kC += dppf<0x124>(kC); kC += dppf<0x128>(kC);
                        if (wr4) yp[yoff] = (bf16)f2bf(kC);
                        yp += 4 * ystep;
                    }
                }
#undef RW_LDREC
                __syncthreads();
            }
        }
#undef RW_ROW
        __syncthreads();
    }
}
FI void ph_rwpost(const TI& T, int l, int vslot, int ybslot) {
    unsigned char* ws = PWS; const float* __restrict__ lnw = PIN(30) + l * 1024; const float* __restrict__ lnb = PIN(31) + l * 1024; const float* __restrict__ BS = (const float*)(ws + WS_BSUM);
    const bf16* __restrict__ YF = slotb(ws, 0); const bf16* __restrict__ YB = slotb(ws, ybslot); const f16* __restrict__ V = sloth(ws, vslot); const bf16* __restrict__ G = slotb(ws, 1); bf16* __restrict__ OUT = slotb(ws, 5);
    const int c0 = T.lane * 16, head = T.lane >> 2;
#pragma unroll 2
    for (int m = T.gw; m < M; m += T.NGW) {
        const size_t o = (size_t)m * 1024 + c0; f32x4 y[4], v[4], g[4]; float s = 0.f;
#pragma unroll
        for (int q = 0; q < 4; ++q) { y[q] = ld_bf4(YF + o + 4 * q) + ld_bf4(YB + o + 4 * q); v[q] = ld_h4(V + o + 4 * q); g[q] = ld_bf4(G + o + 4 * q); s += (y[q][0] + y[q][1]) + (y[q][2] + y[q][3]); }
        const float bsm = BS[(size_t)m * 16 + head];
        const float mean = quadsum(s) * (1.f / 64.f); float vs = 0.f;
#pragma unroll
        for (int q = 0; q < 4; ++q) { y[q] -= mean; vs += (y[q][0] * y[q][0] + y[q][1] * y[q][1]) + (y[q][2] * y[q][2] + y[q][3] * y[q][3]); }
        const float rstd = rsqrtf(quadsum(vs) * (1.f / 64.f) + 64e-5f);
#pragma unroll
        for (int q = 0; q < 4; ++q) { const int cc = c0 + 4 * q;
            const f32x4 yn = y[q] * rstd * *(const f32x4*)(lnw + cc) + *(const f32x4*)(lnb + cc);
            st_bf4(OUT + o + 4 * q, (yn + bsm * v[q]) * g[q]); }
    }
}

FI void ph_natten(const TI& T, int l, bool ctx_out) {
    unsigned char* ws = PWS; const bf16* Q = slotb(ws, 1); const bf16* Kb = slotb(ws, 2); const bf16* Vt = slotb(ws, 3); bf16* Y = slotb(ws, 1);
    const int fr = T.lane & 15, fq = T.lane >> 4, w = T.wave, tid = T.tid;
    LAS unsigned char* Kl = T.lds; LAS unsigned char* Vl = T.lds + 9216;
    const int ntasks = 1024 + (ctx_out ? 32 : 0);
    const int lrow = tid >> 3, lpc = tid & 7;
    for (int task = T.vb; task < ntasks; task += gridDim.x) {
        const bool cq = task >= 1024; int b, h, r = 0, half = 0, qrow0, U0, nwin;
        if (!cq) { const int rg = task & 31; h = (task >> 5) & 15; b = task >> 9; r = rg * 4 + (w >> 1); half = w & 1; qrow0 = b * SEQ + r * 64 + half * 32;
                   U0 = min(max(rg * 4 - 4, 0), 120); nwin = min(max(rg * 4 + 3 - 4, 0), 120) + 8 - U0; }
        else { const int t2 = task - 1024; h = t2 & 15; b = t2 >> 4; qrow0 = ML + b * CTXL + w * 32; U0 = 0; nwin = 0; }
        const int nch = nwin + 4; const int r0 = min(max(r - 4, 0), 120);
        const float* rpb = PIN(9) + ((size_t)l * 16 + h) * 15 * 31;
        LAS float* RL = (LAS float*)(T.lds + 18432);
        __syncthreads();
        if (tid < 465) RL[tid] = rpb[tid];
        bf16x8 Qf[2][2];
#pragma unroll
        for (int qt = 0; qt < 2; ++qt)
#pragma unroll
            for (int ks = 0; ks < 2; ++ks) Qf[qt][ks] = *(const bf16x8*)(Q + (size_t)(qrow0 + qt * 16 + fr) * 1024 + h * 64 + ks * 32 + fq * 8);
        f32x4 O[2][4]; float mr[2], lr[2];
#pragma unroll
        for (int qt = 0; qt < 2; ++qt) { mr[qt] = -1e30f; lr[qt] = 0.f;
#pragma unroll
            for (int dt = 0; dt < 4; ++dt) O[qt][dt] = (f32x4){0.f, 0.f, 0.f, 0.f}; }
#define NAT_GLOAD(c_, kreg_, vreg_) { const bool w_ = (c_) < nwin; const int kr_ = U0 + (c_), cc_ = (c_) - nwin; \
            const bf16* kp_ = w_ ? Kb + (size_t)(b * SEQ + kr_ * 64 + lrow) * 1024 + h * 64 + lpc * 8 : Kb + (size_t)(ML + b * CTXL + cc_ * 64 + lrow) * 1024 + h * 64 + lpc * 8; \
            const bf16* vp_ = w_ ? Vt + ((size_t)(b * 16 + h) * 64 + lrow) * SEQ + kr_ * 64 + lpc * 8 : Vt + (size_t)ML * 1024 + ((size_t)(b * 16 + h) * 64 + lrow) * CTXL + cc_ * 64 + lpc * 8; \
            kreg_ = *(const u32x4*)kp_; vreg_ = *(const u32x4*)vp_; }
        u32x4 kreg, vreg;
        NAT_GLOAD(0, kreg, vreg);
        for (int c = 0; c < nch; ++c) {
            __syncthreads();
            *(LAS u32x4*)(Kl + lrow * 144 + lpc * 16) = kreg; *(LAS u32x4*)(Vl + lrow * 144 + lpc * 16) = vreg;
            __syncthreads();
            if (c + 1 < nch) NAT_GLOAD(c + 1, kreg, vreg);
            const bool win = c < nwin; const int kr = U0 + c;
            const bool active = win ? (kr >= r0 && kr < r0 + 8) : true;
            if (active) {
                f32x4 s[2][4];
                const int ktskip = win ? (half ? 0 : 3) : -1;
#pragma unroll
                for (int kt = 0; kt < 4; ++kt) {
                    if (kt == ktskip) { s[0][kt] = (f32x4){-1e30f, -1e30f, -1e30f, -1e30f}; s[1][kt] = s[0][kt]; continue; }
                    const bf16x8 k0 = *(const LAS bf16x8*)(Kl + (kt * 16 + fr) * 144 + fq * 16), k1 = *(const LAS bf16x8*)(Kl + (kt * 16 + fr) * 144 + 64 + fq * 16);
#pragma unroll
                    for (int qt = 0; qt < 2; ++qt) { f32x4 a = {0.f, 0.f, 0.f, 0.f}; a = __builtin_amdgcn_mfma_f32_16x16x32_bf16(k0, Qf[qt][0], a, 0, 0, 0); a = __builtin_amdgcn_mfma_f32_16x16x32_bf16(k1, Qf[qt][1], a, 0, 0, 0); s[qt][kt] = a; }
                }
                bf16x8 Pf[2][2];
#pragma unroll
                for (int qt = 0; qt < 2; ++qt) {
                    float mx = -1e30f;
                    if (win) {
                        const int qcol = half * 32 + qt * 16 + fr, c0 = min(max(qcol - 8, 0), 48); const LAS float* rp = RL + (kr - r + 7) * 31;
                        const int tl = fq * 4 - c0, dl = fq * 4 - qcol + 15;
#pragma unroll
                        for (int kt = 0; kt < 4; ++kt) {
                            if (kt == ktskip) continue;
#pragma unroll
                            for (int j = 0; j < 4; ++j) { const int t = (kt * 16 + j) + tl; const int oob = (t | (15 - t)) >> 31;
                                const int dc = min(max((kt * 16 + j) + dl, 0), 30); const float val = s[qt][kt][j] * 0.125f + rp[dc];
                                const float mval = __builtin_bit_cast(float, (__builtin_bit_cast(int, val) & ~oob) | (0xf149f2ca & oob));
                                s[qt][kt][j] = mval; mx = fmaxf(mx, mval); }
                        }
                    } else {
#pragma unroll
                        for (int kt = 0; kt < 4; ++kt)
#pragma unroll
                            for (int j = 0; j < 4; ++j) { const float val = s[qt][kt][j] * 0.125f; s[qt][kt][j] = val; mx = fmaxf(mx, val); }
                    }
                    mx = max_fq(mx);
                    const float mnew = fmaxf(mr[qt], mx), alpha = __expf(mr[qt] - mnew); mr[qt] = mnew; float ps = 0.f;
#pragma unroll
                    for (int kt = 0; kt < 4; ++kt)
#pragma unroll
                        for (int j = 0; j < 4; ++j) { const float p = __expf(s[qt][kt][j] - mnew); s[qt][kt][j] = p; ps += p; }
                    lr[qt] = lr[qt] * alpha + ps;
#pragma unroll
                    for (int dt = 0; dt < 4; ++dt) O[qt][dt] *= alpha;
#pragma unroll
                    for (int s2 = 0; s2 < 2; ++s2) { u32x4 pw; pw.x = pk2(s[qt][2 * s2][0], s[qt][2 * s2][1]); pw.y = pk2(s[qt][2 * s2][2], s[qt][2 * s2][3]); pw.z = pk2(s[qt][2 * s2 + 1][0], s[qt][2 * s2 + 1][1]); pw.w = pk2(s[qt][2 * s2 + 1][2], s[qt][2 * s2 + 1][3]);
                        Pf[qt][s2] = __builtin_bit_cast(bf16x8, pw); }
                }
#pragma unroll
                for (int dt = 0; dt < 4; ++dt)
#pragma unroll
                    for (int s2 = 0; s2 < 2; ++s2) {
                        const LAS unsigned char* vp = Vl + (dt * 16 + fr) * 144 + (2 * s2 * 16 + fq * 4) * 2;
                        const u32x2 lo = *(const LAS u32x2*)vp, hi = *(const LAS u32x2*)(vp + 32);
                        u32x4 vw; vw.x = lo.x; vw.y = lo.y; vw.z = hi.x; vw.w = hi.y; const bf16x8 Vf = __builtin_bit_cast(bf16x8, vw);
#pragma unroll
                        for (int qt = 0; qt < 2; ++qt) O[qt][dt] = __builtin_amdgcn_mfma_f32_16x16x32_bf16(Vf, Pf[qt][s2], O[qt][dt], 0, 0, 0);
                    }
            }
        }
#undef NAT_GLOAD
#pragma unroll
        for (int qt = 0; qt < 2; ++qt) { float lt = sum_fq(lr[qt]); const float inv = 1.f / lt;
#pragma unroll
            for (int dt = 0; dt < 4; ++dt) st_bf4(Y + (size_t)(qrow0 + qt * 16 + fr) * 1024 + h * 64 + dt * 16 + fq * 4, O[qt][dt] * inv); }
    }
}

FI void ph_conv(const TI& T, int l) {
    unsigned char* ws = PWS; const float* __restrict__ cw = PIN(10) + (size_t)l * 4 * 1024; const float* __restrict__ cb = PIN(11) + l * 1024;
    const bf16* __restrict__ U = slotb(ws, 2); bf16* __restrict__ UC = slotb(ws, 4);
#pragma unroll 4
    for (int it = T.gtid; it < M * 256; it += T.NT) {
        const int m = it >> 8, cc = (it & 255) * 4; int s0, len, pos; seq_of(m, s0, len, pos);
        f32x4 acc = *(const f32x4*)(cb + cc);
#pragma unroll
        for (int j = 0; j < 4; ++j) { const int pp = pos + j - 2; const bool ok = pp >= 0 && pp < len; const f32x4 x = ld_bf4(U + (size_t)(s0 + (ok ? pp : pos)) * 1024 + cc); acc += (ok ? 1.f : 0.f) * (*(const f32x4*)(cw + j * 1024 + cc) * x); }
        st_bf4(UC + (size_t)m * 1024 + cc, acc);
    }
}
typedef _Float16 f16x2 __attribute__((ext_vector_type(2)));
FI void ph_rgscan1(const TI& T, int l) {
    unsigned char* ws = PWS; f32x2* __restrict__ AB = (f32x2*)(ws + WS_A2);
    for (int it = T.gtid; it < 2 * 264 * 512; it += T.NT) {
        const int c = (it & 511) * 2, q = (it >> 9) % 264, dir = it / (264 * 512);
        const f16* __restrict__ OM = sloth(ws, dir ? 2 : 6); const f16* __restrict__ BB = sloth(ws, dir ? (l == 0 ? 0 : 8) : 7);
        float Ap0 = 1.f, Bp0 = 0.f, Ap1 = 1.f, Bp1 = 0.f;
#pragma unroll 16
        for (int i = 0; i < 64; ++i) { const int m = q * 64 + (dir ? 63 - i : i); const size_t o = (size_t)m * 1024 + c; const f16x2 om = *(const f16x2*)(OM + o), b = *(const f16x2*)(BB + o);
            const float a0 = 1.f - (float)om[0], a1 = 1.f - (float)om[1]; Ap0 *= a0; Bp0 = a0 * Bp0 + (float)b[0]; Ap1 *= a1; Bp1 = a1 * Bp1 + (float)b[1]; }
        const size_t oi = ((size_t)dir * 264 + q) * 1024 + c; AB[oi] = (f32x2){Ap0, Bp0}; AB[oi + 1] = (f32x2){Ap1, Bp1};
    }
}
FI void ph_rgscan2(const TI& T) {
    unsigned char* ws = PWS; const f32x2* AB = (const f32x2*)(ws + WS_A2); float* HIN = (float*)(ws + WS_A2 + (size_t)2 * 264 * 1024 * 8);
    for (int it = T.gtid; it < 4096; it += T.NT) {
        const int c = it & 1023, b = (it >> 10) & 1, dir = it >> 11; float h = 0.f;
        for (int i0 = 0; i0 < 132; i0 += 33) {
            f32x2 ab[33]; int qq[33];
#pragma unroll
            for (int u = 0; u < 33; ++u) { const int i = i0 + u; int q; if (i < 4) q = 256 + b * 4 + (dir ? 3 - i : i); else q = b * 128 + (dir ? 127 - (i - 4) : (i - 4)); qq[u] = q; ab[u] = AB[((size_t)dir * 264 + q) * 1024 + c]; }
#pragma unroll
            for (int u = 0; u < 33; ++u) { HIN[((size_t)dir * 264 + qq[u]) * 1024 + c] = h; h = ab[u].x * h + ab[u].y; }
        }
    }
}
FI void ph_rgscan3(const TI& T, int l) {
    unsigned char* ws = PWS; const float* __restrict__ HIN = (const float*)(ws + WS_A2 + (size_t)2 * 264 * 1024 * 8);
    bf16* __restrict__ UC = slotb(ws, 4); const bf16* __restrict__ GUG = slotb(ws, 3);
    const f16* __restrict__ OMF = sloth(ws, 6); const f16* __restrict__ BBF = sloth(ws, 7); const f16* __restrict__ OMB = sloth(ws, 2); const f16* __restrict__ BBB = sloth(ws, l == 0 ? 0 : 8);
    for (int it = T.gtid; it < 264 * 512; it += T.NT) {
        const int c = (it & 511) * 2, q = it >> 9; const size_t ob = (size_t)(q * 64) * 1024 + c;
        unsigned hfr[64];
        float h0 = HIN[((size_t)0 * 264 + q) * 1024 + c], h1 = HIN[((size_t)0 * 264 + q) * 1024 + c + 1];
#define RS3_F(I0) { f16x2 om[16], b[16]; \
            _Pragma("unroll") for (int u = 0; u < 16; ++u) { om[u] = *(const f16x2*)(OMF + ob + (size_t)((I0) + u) * 1024); b[u] = *(const f16x2*)(BBF + ob + (size_t)((I0) + u) * 1024); } \
            _Pragma("unroll") for (int u = 0; u < 16; ++u) { h0 = (h0 - (float)om[u][0] * h0) + (float)b[u][0]; h1 = (h1 - (float)om[u][1] * h1) + (float)b[u][1]; hfr[(I0) + u] = pk2(h0, h1); } }
        RS3_F(0) RS3_F(16) RS3_F(32) RS3_F(48)
#undef RS3_F
        h0 = HIN[((size_t)1 * 264 + q) * 1024 + c]; h1 = HIN[((size_t)1 * 264 + q) * 1024 + c + 1];
#define RS3_B(I0) { f16x2 om[16], b[16]; unsigned gg[16]; \
            _Pragma("unroll") for (int u = 0; u < 16; ++u) { const size_t o = ob + (size_t)(63 - (I0) - u) * 1024; om[u] = *(const f16x2*)(OMB + o); b[u] = *(const f16x2*)(BBB + o); gg[u] = *(const unsigned*)(GUG + o); } \
            _Pragma("unroll") for (int u = 0; u < 16; ++u) { const size_t o = ob + (size_t)(63 - (I0) - u) * 1024; const unsigned hf = hfr[63 - (I0) - u]; \
                h0 = (h0 - (float)om[u][0] * h0) + (float)b[u][0]; h1 = (h1 - (float)om[u][1] * h1) + (float)b[u][1]; \
                *(unsigned*)(UC + o) = pk2((bf2f(hf & 0xffffu) + h0) * bf2f(gg[u] & 0xffffu), (bf2f(hf >> 16) + h1) * bf2f(gg[u] >> 16)); } }
        RS3_B(0) RS3_B(16) RS3_B(32) RS3_B(48)
#undef RS3_B
    }
}

enum { G_RW = 0, G_NAT, G_LRU, G_GATE, G_BRA, G_BRB, G_BRC, G_OUT, G_FF1, G_FF2 };
struct EpiAll {
    static constexpr bool PERM = false, AFTER_DRAIN = false;
    int mode, l; LAS unsigned char* lds;
    FI void one(unsigned char* ws, float* out, const float* x_in, const float* ctx_in, int row, int col, f32x4 v0, f32x4 v1) const {
        const float* MODl_ = (const float*)(ws + WS_MOD) + (size_t)l * 3 * 6144;
        switch (mode) {
            case G_RW: FRw{ws}(row, col, v0, v1); break;
            case G_NAT: FNat{ws, (const float*)(ws + WS_ROPE)}(row, col, v0, v1); break;
            case G_LRU: FLru{ws}(row, col, v0, v1); break;
            case G_GATE: FGate{ws}(row, col, v0, v1); break;
            case G_BRA: FBr<0>{slotb(ws, 2), slotb(ws, 7)}(row, col, v0, v1); break;
            case G_BRB: FBr<1>{slotb(ws, 3), slotb(ws, 7)}(row, col, v0, v1); break;
            case G_BRC: FBr<2>{slotb(ws, 6), slotb(ws, 7)}(row, col, v0, v1); break;
            case G_OUT: FRes{l == 0 ? x_in : (const float*)out, out, l == 0 ? ctx_in : (const float*)(ws + WS_XCTX), (float*)(ws + WS_XCTX), MODl_ + 2048, l == 0}(row, col, v0, v1); break;
            case G_FF1: FFf1{slotb(ws, 1)}(row, col, v0, v1); break;
            default: FRes{(const float*)out, out, (const float*)(ws + WS_XCTX), (float*)(ws + WS_XCTX), MODl_ + 5120, l == 0}(row, col, v0, v1); break;
        }
    }
    FI void operator()(const pg8::f32x4 (&acc)[2][2][4][2], const pg8::Unit& u, int wr, int wc, int fr, int fq) const {
        unsigned char* ws = (unsigned char*)ldsptr(lds, 44); float* out = (float*)ldsptr(lds, 43); const float* x_in = ldsptr(lds, 0); const float* ctx_in = ldsptr(lds, 2);
#pragma unroll
        for (int ai = 0; ai < 2; ++ai)
#pragma unroll
            for (int m = 0; m < 4; ++m) { const int row = u.pm * 256 + ai * 128 + wr * 64 + m * 16 + fr;
#pragma unroll
                for (int bj = 0; bj < 2; ++bj) { const int col = u.pn * 256 + bj * 128 + wc * 32 + 4 * fq; one(ws, out, x_in, ctx_in, row, col, acc[ai][bj][m][0], acc[ai][bj][m][1]); }
                asm volatile("" ::: "memory"); }
    }
};
FI void run_gemm_all(const TI& T, int mode, int l) {
    unsigned char* ws = PWS;
    int aslot = 0, N = 1024, K = 1024; size_t boff = WS_WIN;
    switch (mode) {
        case G_RW: boff = WS_WIN + (size_t)5120 * 2048; N = 4096; break;
        case G_NAT: N = 3072; break;
        case G_LRU: boff = WS_WIN + (size_t)3072 * 2048; N = 2048; break;
        case G_GATE: boff = WS_WIN + (size_t)9216 * 2048; N = 3072; break;
        case G_BRA: aslot = 1; boff = WS_WBR; break;
        case G_BRB: aslot = 4; boff = WS_WBR + (size_t)1024 * 2048; break;
        case G_BRC: aslot = 5; boff = WS_WBR + (size_t)2048 * 2048; break;
        case G_OUT: aslot = 7; boff = WS_WOUT; break;
        case G_FF1: N = 4096; break;
        default: aslot = 1; boff = WS_WIN + (size_t)4096 * 2048; K = 4096; break;
    }
    const bf16* Abase = (l == 0 && mode <= G_GATE) ? (const bf16*)POUT : slotb(ws, aslot);
    pg8::Gemm g{Abase, (const bf16*)(ws + boff), ML, N, K}; pg8::StaticOrder S; S.init(ML, N, (int)gridDim.x, (int)blockIdx.x);
    EpiAll E{mode, l, T.lds};
    pg8::gemm_phase<EpiAll, pg8::StaticOrder, true, true>((PG8_LAS unsigned char*)T.lds, g, S, E);
    if (l == 1 && mode >= G_GATE) return;
    {
        const bf16* A = Abase + (size_t)ML * K; const bf16* Bt = (const bf16*)(ws + boff);
        const int fr = T.lane & 15, fq = T.lane >> 4, nct = N >> 6, nitems = 8 * nct, kw = K >> 3;
        LAS float* red = (LAS float*)T.lds;
        unsigned char* ws2 = ws; float* out = POUT; const float* x_in = PIN(0); const float* ctx_in = PIN(2);
        for (int it = T.vb; it < nitems; it += gridDim.x) {
            const int rt = it / nct, ct = it % nct, row0 = rt * 64, col0 = ct * 64, kbeg = T.wave * kw;
            f32x4 acc[4][4];
#pragma unroll
            for (int m = 0; m < 4; ++m)
#pragma unroll
                for (int n = 0; n < 4; ++n) acc[m][n] = (f32x4){0.f, 0.f, 0.f, 0.f};
            for (int k0 = kbeg; k0 < kbeg + kw; k0 += 128) {
                bf16x8 af[4][4], bfr[4][4];
#pragma unroll
                for (int ks = 0; ks < 4; ++ks) {
#pragma unroll
                    for (int m = 0; m < 4; ++m) af[ks][m] = *(const bf16x8*)(A + (size_t)(row0 + 16 * m + fr) * K + k0 + ks * 32 + fq * 8);
#pragma unroll
                    for (int n = 0; n < 4; ++n) bfr[ks][n] = *(const bf16x8*)(Bt + (size_t)(col0 + 16 * n + fr) * K + k0 + ks * 32 + fq * 8);
                }
#pragma unroll
                for (int ks = 0; ks < 4; ++ks)
#pragma unroll
                    for (int m = 0; m < 4; ++m)
#pragma unroll
                        for (int n = 0; n < 4; ++n) acc[m][n] = __builtin_amdgcn_mfma_f32_16x16x32_bf16(bfr[ks][n], af[ks][m], acc[m][n], 0, 0, 0);
            }
            { LAS float* dst = red + T.wave * 4096 + T.lane;
#pragma unroll
              for (int m = 0; m < 4; ++m)
#pragma unroll
                  for (int n = 0; n < 4; ++n)
#pragma unroll
                      for (int j = 0; j < 4; ++j) dst[((m * 4 + n) * 4 + j) * 64] = acc[m][n][j]; }
            __syncthreads();
            { const int m = T.wave >> 1, np = T.wave & 1; f32x4 s0 = {0.f, 0.f, 0.f, 0.f}, s1 = {0.f, 0.f, 0.f, 0.f};
#pragma unroll
              for (int w = 0; w < 8; ++w) { const LAS float* src = red + w * 4096 + T.lane;
#pragma unroll
                  for (int j = 0; j < 4; ++j) { s0[j] += src[((m * 4 + 2 * np) * 4 + j) * 64]; s1[j] += src[((m * 4 + 2 * np + 1) * 4 + j) * 64]; } }
              E.one(ws2, out, x_in, ctx_in, ML + row0 + 16 * m + fr, col0 + 32 * np + 4 * fq, s0, s1); }
            __syncthreads();
        }
    }
}

#define XB_TMO      128
#define XB_XCNT(j)  (256  + 64 * (j))
#define XB_XSUB(j)  (1280 + 64 * (j))
#define XB_XGEN(j)  (2304 + 64 * (j))
#define XB_TOP      3328
#define XB_TOPGEN   3392
#define XCD_BAR_WORDS 3456
#define XB_SPIN_CAP (1u << 18)

__device__ __forceinline__ unsigned xb_ld(unsigned* p)              { return __hip_atomic_load(p, __ATOMIC_RELAXED, __HIP_MEMORY_SCOPE_AGENT); }
__device__ __forceinline__ unsigned xb_add(unsigned* p, unsigned v) { return __hip_atomic_fetch_add(p, v, __ATOMIC_RELAXED, __HIP_MEMORY_SCOPE_AGENT); }
__device__ __forceinline__ unsigned xb_xcc_id() { return (unsigned)__builtin_amdgcn_s_getreg((3 << 11) | 20) & 0xFu; }
#define XB_SPIN(cond, bar) do { unsigned _sp = 0; while (cond) { __builtin_amdgcn_s_sleep(1); \
    if ((++_sp & 255u) == 0u) { if (xb_ld(&(bar)[XB_TMO])) break; if (_sp > XB_SPIN_CAP) { atomicAdd(&(bar)[XB_TMO], 1u); break; } } } } while (0)

struct XcdBarrier {
    unsigned* bar; unsigned x;
    volatile LAS unsigned* st;
};

__device__ __forceinline__ XcdBarrier xcd_barrier_post(unsigned* bar, volatile LAS unsigned* st) {
    XcdBarrier b; b.bar = bar; b.x = xb_xcc_id(); b.st = st;
    if (threadIdx.x == 0) (void)xb_add(&bar[XB_XCNT(b.x)], 1u);
    return b;
}
__device__ __forceinline__ void xcd_barrier_complete(unsigned* bar, unsigned x, unsigned& nloc, unsigned& nx) {
    const unsigned G = gridDim.x * gridDim.y * gridDim.z;
    unsigned sum, cnt, mine, sp = 0u;
    for (;;) {
        sum = 0u; cnt = 0u; mine = 0u;
#pragma unroll
        for (unsigned j = 0; j < 16; ++j) { const unsigned c = xb_ld(&bar[XB_XCNT(j)]); sum += c; cnt += (c > 0u) ? 1u : 0u; mine = (j == x) ? c : mine; }
        if (sum == G) break;
        __builtin_amdgcn_s_sleep(1);
        if ((++sp & 255u) == 0u) { if (xb_ld(&bar[XB_TMO])) break; if (sp > XB_SPIN_CAP) { atomicAdd(&bar[XB_TMO], 1u); break; } }
    }
    nloc = mine > 0u ? mine : 1u; nx = cnt > 0u ? cnt : 1u;
}

__device__ __forceinline__ void xcd_barrier(const XcdBarrier& b) {
    asm volatile("s_waitcnt vmcnt(0)" ::: "memory");
    __syncthreads();
    if (threadIdx.x == 0) {
        unsigned* bar = b.bar;
        __builtin_amdgcn_s_waitcnt(0);
        unsigned nloc = b.st[0], nx = b.st[1];
        if (nloc == 0u) { xcd_barrier_complete(bar, b.x, nloc, nx); b.st[0] = nloc; b.st[1] = nx; }
        const unsigned old = xb_add(&bar[XB_XSUB(b.x)], 1u);
        const unsigned gen = old / nloc;
        if (old + 1u == (gen + 1u) * nloc) {
            __builtin_amdgcn_fence(__ATOMIC_RELEASE, "agent");
            asm volatile("s_waitcnt vmcnt(0)" ::: "memory");
            const unsigned og = xb_add(&bar[XB_TOP], 1u);
            const unsigned tg = og / nx;
            if (og + 1u == (tg + 1u) * nx) xb_add(&bar[XB_TOPGEN], 1u);
            else XB_SPIN(xb_ld(&bar[XB_TOPGEN]) == tg, bar);
            __builtin_amdgcn_fence(__ATOMIC_ACQUIRE, "agent");
            xb_add(&bar[XB_XGEN(b.x)], 1u);
            asm volatile("s_waitcnt vmcnt(0)" ::: "memory");
        } else {
            XB_SPIN(xb_ld(&bar[XB_XGEN(b.x)]) == gen, bar);
            __builtin_amdgcn_fence(__ATOMIC_ACQUIRE, "agent");
            asm volatile("s_waitcnt vmcnt(0)" ::: "memory");
        }
    }
    __syncthreads();
}

enum { P_MOD = 0, P_PREP, P_SHIFT, P_LR2, P_RWPREP, P_SCAN, P_GG, P_RWPOST, P_NORM1, P_NAT, P_CONV, P_RGG, P_RS1, P_RS2, P_RS3, P_NORM2W, P_FINAL, P_NOP, P_GEMM0   };
#define PG(g) (P_GEMM0 + (g))
#define NOSYNC 64
#ifndef PROBE_EXTRA
#define PROBE_EXTRA(L)
#endif
#ifndef PB_NAT
#define PB_NAT(L)
#endif
#ifndef PB_GRW
#define PB_GRW(L)
#endif
#ifndef PB_SMALL1
#define PB_SMALL1(L)
#define PB_SMALL2(L)
#define PB_SMALL3(L)
#endif
#ifndef DUPP
#define DUPP(x)
#endif
#ifndef DUPG
#define DUPG(x)
#endif
#ifndef DUPS
#define DUPS(x)
#endif
#ifndef DUPA
#define DUPA(x)
#endif
#ifndef DUPC
#define DUPC(x)
#endif
#ifndef DUPB
#define DUPB(x)
#endif
#ifndef DUP
#define DUP(x)
#endif
#define NORM1A(L) NORM1A_##L
#define NORM1A_0
#define NORM1A_32 32 | P_NORM1,
#define LAYER(L) (L) | P_PREP, DUPP((L) | P_PREP) (L) | PG(G_RW), PB_GRW(L) (L) | P_SHIFT, DUPA((L) | P_SHIFT) (L) | P_LR2, DUPB((L) | P_LR2) (L) | P_SCAN, DUPS((L) | P_SCAN) (L) | P_RWPOST, DUPA((L) | P_RWPOST) NORM1A(L) (L) | PG(G_NAT), (L) | P_NAT, PB_NAT(L) \
    (L) | PG(G_LRU), (L) | P_CONV, DUPA((L) | P_CONV) (L) | P_RGG, DUPB((L) | P_RGG) (L) | P_RS2, DUPC((L) | P_RS2) (L) | P_RS3, (L) | PG(G_GATE), (L) | PG(G_BRA) | NOSYNC, DUPG((L) | PG(G_BRA) | NOSYNC) (L) | PG(G_BRB) | NOSYNC, (L) | PG(G_BRC), \
    (L) | PG(G_OUT), (L) | P_NORM2W, DUPP((L) | P_NORM2W) (L) | PG(G_FF1), (L) | PG(G_FF2), PROBE_EXTRA(L)
__constant__ unsigned char PROG[] = { P_MOD, LAYER(0) LAYER(32) 32 | P_FINAL };

__global__ void __launch_bounds__(NTHR, 2) mega(Params P) {
    extern __shared__ __attribute__((aligned(16))) unsigned char lds_raw[];
    cg::grid_group grid = cg::this_grid();
    LAS unsigned char* const lds0 = (LAS unsigned char*)lds_raw;
    { const int tid0 = threadIdx.x;
      LAS unsigned* tb = (LAS unsigned*)(lds0 + 131072);
      if (tid0 < 43) { const unsigned long long v = (unsigned long long)P.in[tid0]; tb[2 * tid0] = (unsigned)v; tb[2 * tid0 + 1] = (unsigned)(v >> 32); }
      if (tid0 == 43) { const unsigned long long v = (unsigned long long)P.out; tb[86] = (unsigned)v; tb[87] = (unsigned)(v >> 32); }
      if (tid0 == 44) { const unsigned long long v = (unsigned long long)P.ws; tb[88] = (unsigned)v; tb[89] = (unsigned)(v >> 32); } }
    { LAS unsigned* tb = (LAS unsigned*)(lds0 + 131072); if (threadIdx.x == 64) { tb[256] = 0u; tb[257] = 0u; } }
    __syncthreads();
    XcdBarrier xbar = xcd_barrier_post((unsigned*)(P.ws + WS_BAR), (volatile LAS unsigned*)(lds0 + 131072 + 1024));
    constexpr int NSTEPS = (int)sizeof(PROG);
    for (int st = 0; st < NSTEPS; ++st) {
        const unsigned code = PROG[st]; const int op = code & 31, l = (code >> 5) & 1;
        {
            const TI T = mk_ti(lds0);
            const int vslot = l == 0 ? 8 : 7, ybslot = l == 0 ? 7 : 8;
            unsigned char* ws = PWS;
            const bf16* L2 = (const bf16*)(ws + WS_WLR2); const bf16* A2 = (const bf16*)(ws + WS_A2);
            switch (op) {
                case P_MOD: ph_mod(T); break;
                case P_PREP: ph_weights_mixer(T, l); ph_norm(T, l, 0, l == 0 ? (bf16*)POUT : slotb(ws, 0)); break;
                case P_SHIFT: ph_shiftmix(T, l, vslot); break;
                case P_LR2:
                    sgemm<64>(T, A2, 448, 0, 4, L2 + LR2_ZF, 64, FLr2All{ws, PIN(19) + (size_t)l * 2048, PIN(22) + (size_t)l * 2048}, 4);
                    if (l > 0) sgemm_t<32, 2>(T, A2, 448, 416, 0, L2 + LR2_V, 16, FVmix{sloth(ws, vslot), sloth(ws, 8), PIN(32) + (l - 1) * 1024});
                    break;
                case P_RWPREP: ph_rwprep(T, l, vslot); break;
                case P_SCAN: ph_rwscan(T, l, vslot, ybslot); break;
                case P_GG: sgemm<160>(T, A2, 448, 256, 0, L2 + LR2_G, 16, FPlainB{slotb(ws, 1)}); break;
                case P_RWPOST: sgemm_t<160, 2>(T, A2, 448, 256, 0, L2 + LR2_G, 16, FPost{slotb(ws, 0), slotb(ws, ybslot), sloth(ws, vslot), slotb(ws, 5), (const float*)(ws + WS_BSUM), (const float*)(ws + WS_BSB), PIN(30) + l * 1024, PIN(31) + l * 1024, T.lane}); break;
                case P_NORM1: ph_norm(T, l, 0, slotb(ws, 0)); break;
                case P_NAT: ph_natten(T, l, l == 0); break;
                case P_CONV: ph_conv(T, l); break;
                case P_RGG: sgemm<64>(T, slotb(ws, 4), 1024, 0, 16, (const bf16*)(ws + WS_WRG), 64, FRgAB{ws, PIN(13) + (size_t)l * 2048, PIN(15) + (size_t)l * 2048, (const float*)(ws + WS_SP8), slotb(ws, 4), l == 0 ? 0 : 8, (LAS f32x2*)(T.lds + T.wave * 16384), T.lane}, 1); break;
                case P_RS1: ph_rgscan1(T, l); break;
                case P_RS2: ph_rgscan2(T); break;
                case P_RS3: ph_rgscan3(T, l); break;
                case P_NORM2W: ph_norm(T, l, 1, slotb(ws, 0)); ph_weights_mlp(T, l); break;
                case P_FINAL: ph_final(T); break;
                case P_NOP: break;
                default: run_gemm_all(T, op - P_GEMM0, l); break;
            }
        }
        if (!(code & NOSYNC) && st + 1 < NSTEPS) { if (P.ph_lo == 0x7fffffff) grid.sync();
            else { XcdBarrier b2; b2.bar = (unsigned*)(ldsptr(lds0, 44)) + WS_BAR / 4; b2.x = xb_xcc_id(); b2.st = (volatile LAS unsigned*)(lds0 + 131072 + 1024); xcd_barrier(b2); } }
    }
}

extern "C" void kernel_launch(void* const* d_in, const int* in_sizes, int n_in, void* d_out, int out_size, void* d_ws, size_t ws_size, hipStream_t stream) {
    static int grid = 0;
    if (grid == 0) {
        if (n_in != 43 || out_size != ML * 1024 || ws_size < WS_END) { fprintf(stderr, "kernel_launch: unexpected problem (n_in %d, out %d, ws %zu < %zu)\n", n_in, out_size, ws_size, (size_t)WS_END); grid = -1; return; }
        int dev = 0, cus = 0, per_cu = 0;
        (void)hipGetDevice(&dev); (void)hipDeviceGetAttribute(&cus, hipDeviceAttributeMultiprocessorCount, dev);
        if (hipFuncSetAttribute((const void*)mega, hipFuncAttributeMaxDynamicSharedMemorySize, LDS_BYTES) != hipSuccess) { fprintf(stderr, "kernel_launch: hipFuncSetAttribute failed\n"); grid = -1; return; }
        if (hipOccupancyMaxActiveBlocksPerMultiprocessor(&per_cu, (const void*)mega, NTHR, LDS_BYTES) != hipSuccess || per_cu < 1) { fprintf(stderr, "kernel_launch: occupancy query says %d\n", per_cu); grid = -1; return; }
        grid = cus;
    }
    if (grid < 0) return;
    Params p{};
    for (int i = 0; i < 43; ++i) p.in[i] = (const float*)d_in[i];
    p.out = (float*)d_out; p.ws = (unsigned char*)d_ws; p.ph_lo = 0; p.ph_hi = 1000;
    if (hipMemsetAsync((char*)d_ws + WS_BAR, 0, 16384, stream) != hipSuccess) { fprintf(stderr, "kernel_launch: memset failed\n"); return; }
    void* args[] = {&p};
    hipError_t e = hipLaunchCooperativeKernel((const void*)mega, dim3(grid), dim3(NTHR), args, LDS_BYTES, stream);
    if (e != hipSuccess) fprintf(stderr, "cooperative launch failed: %s (grid %d)\n", hipGetErrorString(e), grid);
}
```

```cpp
#include <hip/hip_runtime.h>
#include <hip/hip_cooperative_groups.h>
#include <cstdio>
#include <cstdint>
namespace cg = cooperative_groups;

#define GAS __attribute__((address_space(1)))
#define LAS __attribute__((address_space(3)))
typedef unsigned short bf16;
typedef _Float16 f16;
typedef float f32x4 __attribute__((ext_vector_type(4)));
typedef float f32x2 __attribute__((ext_vector_type(2)));
typedef short bf16x8 __attribute__((ext_vector_type(8)));
typedef short s16x4 __attribute__((ext_vector_type(4)));
typedef _Float16 f16x4 __attribute__((ext_vector_type(4)));
typedef unsigned u32x2 __attribute__((ext_vector_type(2)));
typedef unsigned u32x4 __attribute__((ext_vector_type(4)));
#define LDS_WAIT() asm volatile("s_waitcnt lgkmcnt(0)" ::: "memory")

constexpr int DM = 1024, SEQ = 8192, CTXL = 256, ML = 16384, MC = 512, M = ML + MC, NIN = 11264, NEXT = 12288, DFF = 4096;
constexpr int NWAVES = 8, NTHR = 512;
constexpr size_t SLOT = (size_t)M * 1024 * 2;
constexpr size_t WS_WIN = 9 * SLOT;
constexpr size_t WS_WBR = WS_WIN + (size_t)NEXT * 1024 * 2;
constexpr size_t WS_WOUT = WS_WBR + 3ull * 1024 * 1024 * 2;
constexpr size_t WS_WRG = WS_WOUT + 1024ull * 1024 * 2;
constexpr size_t WS_WLR2 = WS_WRG + 4096ull * 64 * 2;
constexpr size_t WS_A2 = WS_WLR2 + (4ull * 1024 * 64 + 1024 * 160 + 1024 * 32) * 2;
constexpr size_t WS_XCTX = WS_A2 + (size_t)M * 448 * 2;
constexpr size_t WS_MOD = WS_XCTX + 512ull * 1024 * 4;
constexpr size_t WS_ROPE = WS_MOD + 2ull * 3 * 6144 * 4;
constexpr size_t WS_BSUM = WS_ROPE + 128ull * 16 * 2 * 4;
constexpr size_t WS_RN = WS_BSUM + (size_t)M * 16 * 4;
constexpr size_t WS_SP8 = WS_RN + (size_t)M * 16 * 4;
constexpr size_t WS_BAR = WS_SP8 + 2048 * 4;
constexpr size_t WS_BSB = WS_BAR + 16384;
constexpr size_t WS_END = WS_BSB + (size_t)M * 16 * 4;
constexpr size_t LR2_ZF = 0, LR2_ZB = 1024 * 64, LR2_AF = 2 * 1024 * 64, LR2_AB = 3 * 1024 * 64, LR2_G = 4 * 1024 * 64, LR2_V = 4 * 1024 * 64 + 1024 * 160;
constexpr int LDS_BYTES = 131072 + 4096;

__device__ __forceinline__ unsigned f2bf(float f) { unsigned r; asm("v_cvt_pk_bf16_f32 %0, %1, %1" : "=v"(r) : "v"(f)); return r & 0xffffu; }
__device__ __forceinline__ unsigned pk2(float lo, float hi) { unsigned r; asm("v_cvt_pk_bf16_f32 %0, %1, %2" : "=v"(r) : "v"(lo), "v"(hi)); return r; }
__device__ __forceinline__ float bf2f(unsigned b) { return __builtin_bit_cast(float, b << 16); }
__device__ __forceinline__ void st_bf4(bf16* p, f32x4 v) { u32x2 w; w.x = pk2(v[0], v[1]); w.y = pk2(v[2], v[3]); *(u32x2*)p = w; }
__device__ __forceinline__ f32x4 ld_bf4(const bf16* p) { u32x2 w = *(const u32x2*)p; f32x4 v; v[0] = bf2f(w.x & 0xffffu); v[1] = bf2f(w.x >> 16); v[2] = bf2f(w.y & 0xffffu); v[3] = bf2f(w.y >> 16); return v; }
__device__ __forceinline__ void st_h4(f16* p, f32x4 v) { f16x4 h; h[0] = (f16)v[0]; h[1] = (f16)v[1]; h[2] = (f16)v[2]; h[3] = (f16)v[3]; *(f16x4*)p = h; }
__device__ __forceinline__ f32x4 ld_h4(const f16* p) { f16x4 h = *(const f16x4*)p; f32x4 v; v[0] = (float)h[0]; v[1] = (float)h[1]; v[2] = (float)h[2]; v[3] = (float)h[3]; return v; }
__device__ __forceinline__ float sigmoidf_(float x) { return __builtin_amdgcn_rcpf(1.f + __expf(-x)); }
template <int CTRL> __device__ __forceinline__ float dppf(float x) { return __builtin_bit_cast(float, __builtin_amdgcn_update_dpp(0, __builtin_bit_cast(int, x), CTRL, 0xf, 0xf, true)); }
__device__ __forceinline__ float quadsum(float x) { x += dppf<0xB1>(x); x += dppf<0x4E>(x); return x; }
__device__ __forceinline__ float allred16(float x) { x += dppf<0xB1>(x); x += dppf<0x4E>(x); x += dppf<0x141>(x); x += dppf<0x140>(x); return x; }
__device__ __forceinline__ float shx(float v, int mask, int lane) { return __builtin_bit_cast(float, __builtin_amdgcn_ds_bpermute((lane ^ mask) << 2, __builtin_bit_cast(int, v))); }
__device__ __forceinline__ void swap16(float x, float& a, float& b) { a = x; b = x; asm volatile("s_nop 1\n\tv_permlane16_swap_b32 %0, %1\n\ts_nop 1" : "+v"(a), "+v"(b)); }
__device__ __forceinline__ void swap32(float x, float& a, float& b) { a = x; b = x; asm volatile("s_nop 1\n\tv_permlane32_swap_b32 %0, %1\n\ts_nop 1" : "+v"(a), "+v"(b)); }
__device__ __forceinline__ float sum_fq(float x) { float a, b; swap16(x, a, b); x = a + b; swap32(x, a, b); return a + b; }
__device__ __forceinline__ float max_fq(float x) { float a, b; swap16(x, a, b); x = fmaxf(a, b); swap32(x, a, b); return fmaxf(a, b); }
__device__ __forceinline__ float wave_sum(float v, int lane) {
    v = allred16(v); return sum_fq(v);
}
__device__ __forceinline__ void seq_of(int m, int& s0, int& len, int& pos) {
    if (m < ML) { s0 = m & ~(SEQ - 1); len = SEQ; pos = m & (SEQ - 1); }
    else { s0 = ML + ((m - ML) & ~(CTXL - 1)); len = CTXL; pos = (m - ML) & (CTXL - 1); }
}
namespace pg8 {
#define PG8_LAS __attribute__((address_space(3)))
typedef unsigned short bf16_t;
typedef short bf16x8 __attribute__((ext_vector_type(8)));
typedef float f32x4 __attribute__((ext_vector_type(4)));
typedef unsigned u32x4 __attribute__((ext_vector_type(4)));
constexpr int BM = 256, BK = 64, HALF = 128, HTB = HALF * BK * 2  , STAGE_BYTES = 8 * HTB, NXCD = 8, WGM = 8;

__host__ __device__ __forceinline__ int lds_byte(int r, int c) { const int st = (r >> 4) * 2 + (c >> 5), rr = r & 15, cc = c & 31, ob = rr * 64 + cc * 2; return st * 1024 + (ob ^ (((ob >> 9) & 1) << 5)); }
__host__ __device__ __forceinline__ void stage_rc(int b, int& R, int& C) { const int st = b / 1024, sb = b % 1024, swz = sb ^ (((sb >> 9) & 1) << 5); R = (st >> 1) * 16 + swz / 64; C = (st & 1) * 32 + (swz % 64) / 2; }
__host__ __device__ __forceinline__ int perm32(int rho) { const int n = rho >> 4, i = rho & 15; return 8 * (i >> 2) + 4 * n + (i & 3); }

struct Unit { int pm, pn; };
struct Gemm { const bf16_t* A; const bf16_t* Bt; int M, N, K; };

struct StaticOrder {
    int nM, nN, nwg, G, c;
    __host__ __device__ void init(int M, int N, int G_, int c_) { nM = M / BM; nN = N / BM; nwg = nM * nN; G = G_; c = c_; }
    __host__ __device__ bool next(int i, Unit& u) const {
        const long L = (long)i * G + c; if (L >= nwg) return false;
        int wgid = (int)L; { const int q = nwg / NXCD, r = nwg % NXCD, xcd = wgid % NXCD, off = wgid / NXCD; wgid = (xcd < r ? xcd * (q + 1) : r * (q + 1) + (xcd - r) * q) + off; }
        const int nig = WGM * nN, gid = wgid / nig, fm = gid * WGM, gsz = (nM - fm) < WGM ? (nM - fm) : WGM;
        u.pm = fm + ((wgid % nig) % gsz); u.pn = (wgid % nig) / gsz; return true;
    }
    __device__ __forceinline__ void a_ready(const Unit&) const {}
    __device__ __forceinline__ void done(const Unit&) const {}
};
template <class Epi, class Sched, bool ALIGN_EPI = false, bool SP2 = false>
__device__ __forceinline__ void gemm_phase(PG8_LAS unsigned char* lds, const Gemm g, const Sched& S, const Epi& E) {
    int tid_ = threadIdx.x; asm volatile("" : "+v"(tid_)); const int tid = tid_, wid = __builtin_amdgcn_readfirstlane(tid >> 6), lane = tid & 63, wr = wid >> 2, wc = wid & 3, fr = lane & 15, fq = lane >> 4;
    const int K = g.K, nt = K / BK;
    unsigned voffA[2], voffB[2];
#pragma unroll
    for (int i = 0; i < 2; ++i) { int R, C; stage_rc(tid * 16 + i * 8192, R, C); const int Rb = Epi::PERM ? ((R & ~31) + perm32(R & 31)) : R;
        voffA[i] = (unsigned)(R * K + C) * 2u; voffB[i] = (unsigned)(Rb * K + C) * 2u; }
    const size_t kstep = (size_t)(BK * 2);
    const size_t hstep = (size_t)HALF * K * 2;
    const size_t tstep = 2 * hstep;
    const unsigned ldsw = (unsigned)wid * 1024u;
    const int aoff = lds_byte(wr * 64 + fr, fq * 8), boff = lds_byte(wc * 32 + fr, fq * 8);
#define PG8_SA(b, h) (((b) * 2 + (h)) * HTB)
#define PG8_SB(b, h) ((4 + (b) * 2 + (h)) * HTB)
#define PG8_STAGE(bufoff, gbase, voff) do { _Pragma("unroll") for (int _i = 0; _i < 2; ++_i) \
        __builtin_amdgcn_global_load_lds((const unsigned*)((const char*)(gbase) + (voff)[_i]), (PG8_LAS unsigned*)(lds + (bufoff) + ldsw + _i * 8192), 16, 0, 0); } while (0)
#define PG8_LDA(dst, b, h) do { _Pragma("unroll") for (int m = 0; m < 4; ++m) _Pragma("unroll") for (int k = 0; k < 2; ++k) dst[m][k] = *(const PG8_LAS bf16x8*)(lds + PG8_SA(b, h) + aoff + m * 2048 + k * 1024); } while (0)
#define PG8_LDB(dst, b, h) do { _Pragma("unroll") for (int n = 0; n < 2; ++n) _Pragma("unroll") for (int k = 0; k < 2; ++k) dst[n][k] = *(const PG8_LAS bf16x8*)(lds + PG8_SB(b, h) + boff + n * 2048 + k * 1024); } while (0)
#define PG8_MMA(ai, bj, At, Bt) do { __builtin_amdgcn_s_setprio(1); _Pragma("unroll") for (int m = 0; m < 4; ++m) _Pragma("unroll") for (int n = 0; n < 2; ++n) _Pragma("unroll") for (int k = 0; k < 2; ++k) \
        acc[ai][bj][m][n] = __builtin_amdgcn_mfma_f32_16x16x32_bf16(Bt[n][k], At[m][k], acc[ai][bj][m][n], 0, 0, 0); __builtin_amdgcn_s_setprio(0); } while (0)
#define PG8_WAIT_V(n) asm volatile("s_waitcnt vmcnt(" #n ")" ::: "memory")
#define PG8_WAIT_L(n) asm volatile("s_waitcnt lgkmcnt(" #n ")" ::: "memory")
#define PG8_BAR __builtin_amdgcn_s_barrier()
#define PG8_SCHED __builtin_amdgcn_sched_barrier(0)
    Unit cur, nxt; int ui = 0;
    if (!S.next(0, cur)) return;
    f32x4 acc[2][2][4][2];
#pragma unroll
    for (int a = 0; a < 2; ++a)
#pragma unroll
        for (int b = 0; b < 2; ++b)
#pragma unroll
            for (int m = 0; m < 4; ++m)
#pragma unroll
                for (int n = 0; n < 2; ++n) acc[a][b][m][n] = (f32x4){0.f, 0.f, 0.f, 0.f};
    bf16x8 At[4][2], B0[2][2], B1[2][2];
    const char* cA = (const char*)g.A + (size_t)cur.pm * tstep; const char* cB = (const char*)g.Bt + (size_t)cur.pn * tstep;
    S.a_ready(cur);
    if constexpr (SP2) {
        PG8_STAGE(PG8_SB(0, 0), cB, voffB); PG8_STAGE(PG8_SB(0, 1), cB + hstep, voffB); PG8_STAGE(PG8_SA(0, 0), cA, voffA); PG8_STAGE(PG8_SA(0, 1), cA + hstep, voffA);
        if (wr == 1) PG8_BAR;
        PG8_WAIT_V(2); PG8_BAR;
        PG8_STAGE(PG8_SB(1, 0), cB + kstep, voffB); PG8_STAGE(PG8_SA(1, 0), cA + kstep, voffA); PG8_STAGE(PG8_SB(1, 1), cB + hstep + kstep, voffB);
        PG8_WAIT_V(6); PG8_BAR;
    } else {
        PG8_STAGE(PG8_SB(0, 0), cB, voffB); PG8_STAGE(PG8_SA(0, 0), cA, voffA); PG8_STAGE(PG8_SB(0, 1), cB + hstep, voffB); PG8_STAGE(PG8_SA(0, 1), cA + hstep, voffA);
        if (wr == 1) PG8_BAR;
        PG8_WAIT_V(4); PG8_BAR;
        PG8_STAGE(PG8_SB(1, 0), cB + kstep, voffB); PG8_STAGE(PG8_SA(1, 0), cA + kstep, voffA); PG8_STAGE(PG8_SB(1, 1), cB + hstep + kstep, voffB);
        PG8_WAIT_V(6); PG8_BAR;
    }
    for (;;) {
        const bool has_next = S.next(ui + 1, nxt);
        const char* nA = has_next ? (const char*)g.A + (size_t)nxt.pm * tstep : cA; const char* nB = has_next ? (const char*)g.Bt + (size_t)nxt.pn * tstep : cB;
        for (int t = 0; t < nt; t += 2) {
            const bool last = (t == nt - 2);
            const char* a1 = cA + (size_t)(t + 1) * kstep;
            const char* a2 = last ? nA : cA + (size_t)(t + 2) * kstep; const char* b2 = last ? nB : cB + (size_t)(t + 2) * kstep;
            const char* a3 = a2 + kstep; const char* b3 = b2 + kstep;
            if (last && has_next) S.a_ready(nxt);
            if constexpr (SP2) {
            PG8_LDB(B0, 0, 0); PG8_LDB(B1, 0, 1); PG8_SCHED; PG8_LDA(At, 0, 0); PG8_STAGE(PG8_SA(1, 1), a1 + hstep, voffA);
            PG8_WAIT_V(8); PG8_WAIT_L(0); PG8_BAR; PG8_MMA(0, 0, At, B0); PG8_MMA(0, 1, At, B1); PG8_BAR; PG8_SCHED;
            PG8_LDA(At, 0, 1); PG8_STAGE(PG8_SB(0, 0), b2, voffB); PG8_STAGE(PG8_SB(0, 1), b2 + hstep, voffB); PG8_STAGE(PG8_SA(0, 0), a2, voffA);
            PG8_WAIT_V(8); PG8_WAIT_L(0); PG8_BAR; PG8_MMA(1, 0, At, B0); PG8_MMA(1, 1, At, B1); PG8_BAR; PG8_SCHED;
            PG8_LDB(B0, 1, 0); PG8_LDB(B1, 1, 1); PG8_SCHED; PG8_LDA(At, 1, 0); PG8_STAGE(PG8_SA(0, 1), a2 + hstep, voffA);
            PG8_WAIT_V(8); PG8_WAIT_L(0); PG8_BAR; PG8_MMA(0, 0, At, B0); PG8_MMA(0, 1, At, B1); PG8_BAR; PG8_SCHED;
            PG8_LDA(At, 1, 1); PG8_STAGE(PG8_SB(1, 0), b3, voffB); PG8_STAGE(PG8_SB(1, 1), b3 + hstep, voffB); PG8_STAGE(PG8_SA(1, 0), a3, voffA);
            PG8_WAIT_V(8); PG8_WAIT_L(0); PG8_BAR; PG8_MMA(1, 0, At, B0); PG8_MMA(1, 1, At, B1); PG8_BAR; PG8_SCHED;
            } else {
            PG8_LDB(B0, 0, 0); PG8_SCHED; PG8_LDA(At, 0, 0); PG8_STAGE(PG8_SA(1, 1), a1 + hstep, voffA);
            PG8_WAIT_L(8); PG8_BAR; PG8_WAIT_L(0); PG8_MMA(0, 0, At, B0); PG8_BAR; PG8_SCHED;
            PG8_LDB(B1, 0, 1); PG8_STAGE(PG8_SB(0, 0), b2, voffB);
            PG8_BAR; PG8_WAIT_L(0); PG8_MMA(0, 1, At, B1); PG8_BAR;
            PG8_LDA(At, 0, 1); PG8_STAGE(PG8_SA(0, 0), a2, voffA);
            PG8_BAR; PG8_WAIT_L(0); PG8_MMA(1, 0, At, B0); PG8_BAR; PG8_SCHED;
            PG8_STAGE(PG8_SB(0, 1), b2 + hstep, voffB);
            PG8_WAIT_V(6); PG8_BAR; PG8_MMA(1, 1, At, B1); PG8_BAR;
            PG8_LDB(B0, 1, 0); PG8_SCHED; PG8_LDA(At, 1, 0); PG8_STAGE(PG8_SA(0, 1), a2 + hstep, voffA);
            PG8_WAIT_L(8); PG8_BAR; PG8_WAIT_L(0); PG8_MMA(0, 0, At, B0); PG8_BAR; PG8_SCHED;
            PG8_LDB(B1, 1, 1); PG8_STAGE(PG8_SB(1, 0), b3, voffB);
            PG8_BAR; PG8_WAIT_L(0); PG8_MMA(0, 1, At, B1); PG8_BAR;
            PG8_LDA(At, 1, 1); PG8_STAGE(PG8_SA(1, 0), a3, voffA);
            PG8_BAR; PG8_WAIT_L(0); PG8_MMA(1, 0, At, B0); PG8_BAR; PG8_SCHED;
            PG8_STAGE(PG8_SB(1, 1), b3 + hstep, voffB);
            PG8_WAIT_V(6); PG8_BAR; PG8_MMA(1, 1, At, B1); PG8_BAR;
            }
        }
        if constexpr (ALIGN_EPI) { if (wr == 0) PG8_BAR; }
        if constexpr (!Epi::AFTER_DRAIN) { E(acc, cur, wr, wc, fr, fq); S.done(cur); }
        if (!has_next) break;
#pragma unroll
        for (int a = 0; a < 2; ++a)
#pragma unroll
            for (int b = 0; b < 2; ++b)
#pragma unroll
                for (int m = 0; m < 4; ++m)
#pragma unroll
                    for (int n = 0; n < 2; ++n) acc[a][b][m][n] = (f32x4){0.f, 0.f, 0.f, 0.f};
        cur = nxt; cA = nA; cB = nB; ++ui;
        if constexpr (ALIGN_EPI) { if (wr == 1) PG8_BAR; }
    }
    PG8_WAIT_V(0);
    if constexpr (!ALIGN_EPI) { if (wr == 0) PG8_BAR; }
    PG8_BAR;
    if constexpr (Epi::AFTER_DRAIN) { E.fused(acc, cur, wr, wc, fr, fq, lds, wid, lane); S.done(cur); }
#undef PG8_SA
#undef PG8_SB
#undef PG8_STAGE
#undef PG8_LDA
#undef PG8_LDB
#undef PG8_MMA
#undef PG8_WAIT_V
#undef PG8_WAIT_L
#undef PG8_BAR
#undef PG8_SCHED
}
}

#define FI __device__ __forceinline__
struct Params { const float* in[43]; float* out; unsigned char* ws; int ph_lo, ph_hi; };
struct TI { int tid, lane, wave, gw, NGW, gtid, NT, vb; LAS unsigned char* lds; };
FI const float* ldsptr(LAS unsigned char* lds, int i) { volatile LAS unsigned* p = (volatile LAS unsigned*)(lds + 131072) + 2 * i; const unsigned lo = __builtin_amdgcn_readfirstlane(p[0]), hi = __builtin_amdgcn_readfirstlane(p[1]); return (const float*)(GAS const float*)(((unsigned long long)hi << 32) | lo); }
FI TI mk_ti(LAS unsigned char* lds) { TI T; int tid = threadIdx.x; asm volatile("" : "+v"(tid)); int bx = blockIdx.x; asm volatile("" : "+s"(bx)); int gx = gridDim.x; asm volatile("" : "+s"(gx));
    const int vb = (gx & 7) == 0 ? (bx & 7) * (gx >> 3) + (bx >> 3) : bx; T.vb = vb;
    T.tid = tid; T.lane = tid & 63; T.wave = __builtin_amdgcn_readfirstlane(tid >> 6); T.gw = vb * NWAVES + T.wave; T.NGW = gx * NWAVES; T.gtid = vb * NTHR + tid; T.NT = gx * NTHR; unsigned lo_ = (unsigned)(unsigned long long)lds; asm volatile("" : "+s"(lo_)); T.lds = (LAS unsigned char*)(unsigned long long)lo_; return T; }
#define PIN(i) ldsptr(T.lds, (i))
#define POUT ((float*)ldsptr(T.lds, 43))
#define PWS ((unsigned char*)ldsptr(T.lds, 44))

FI bf16* slotb(unsigned char* ws, int i) { return (bf16*)(ws + (size_t)i * SLOT); }
FI f16* sloth(unsigned char* ws, int i) { return (f16*)(ws + (size_t)i * SLOT); }

FI void ph_mod(const TI& T) {
    const float* c = PIN(1); const float* cctx = PIN(3); const float* w_ada = PIN(4); const float* b_ada = PIN(5);
    float* MOD = (float*)(PWS + WS_MOD);
    LAS float* red = (LAS float*)T.lds;
    for (int task = T.vb; task < 192; task += gridDim.x) {
        const int l = task / 96, n = (task % 96) * 64 + T.lane;
        float a0 = 0.f, a1 = 0.f, a2 = 0.f;
        const float* wp = w_ada + ((size_t)l * 1024 + T.wave * 128) * 6144 + n;
#pragma unroll 16
        for (int kk = 0; kk < 128; ++kk) {
            const int k = T.wave * 128 + kk;
            const float wv = __builtin_nontemporal_load(wp + (size_t)kk * 6144);
            const float c0 = c[k], c1 = c[1024 + k], c2 = cctx[k];
            a0 += c0 * sigmoidf_(c0) * wv; a1 += c1 * sigmoidf_(c1) * wv; a2 += c2 * sigmoidf_(c2) * wv;
        }
        red[(T.wave * 3 + 0) * 64 + T.lane] = a0; red[(T.wave * 3 + 1) * 64 + T.lane] = a1; red[(T.wave * 3 + 2) * 64 + T.lane] = a2;
        __syncthreads();
        if (T.wave == 0) {
#pragma unroll
            for (int s = 0; s < 3; ++s) { float t = 0.f;
#pragma unroll
                for (int w = 0; w < 8; ++w) t += red[(w * 3 + s) * 64 + T.lane];
                MOD[((size_t)l * 3 + s) * 6144 + n] = t + b_ada[l * 6144 + n]; }
        }
        __syncthreads();
    }
    float* tab = (float*)(PWS + WS_ROPE);
    for (int i = T.gtid; i < 2048; i += T.NT) { const int pos = i >> 4, f = i & 15; const float invf = powf(10000.f, -(float)f / 16.f); const float ang = (float)pos * invf; tab[2 * i] = cosf(ang); tab[2 * i + 1] = sinf(ang); }
}

template <class SRC>
FI void transpose_item(const SRC& src, int K, bf16* WT, int k0, int n0, LAS float* scr, int lane) {
    float tv[32];
#pragma unroll
    for (int i = 0; i < 32; ++i) tv[i] = src(k0 + 2 * i + (lane >> 5), n0 + (lane & 31));
#pragma unroll
    for (int i = 0; i < 32; ++i) scr[(2 * i + (lane >> 5)) * 33 + (lane & 31)] = tv[i];
    LDS_WAIT(); asm volatile("" ::: "memory");
    const int c = lane & 7;
#pragma unroll
    for (int j = 0; j < 4; ++j) { const int n = (lane >> 3) + 8 * j; const LAS float* s = scr + (8 * c) * 33 + n;
        u32x4 o; o.x = pk2(s[0 * 33], s[1 * 33]); o.y = pk2(s[2 * 33], s[3 * 33]); o.z = pk2(s[4 * 33], s[5 * 33]); o.w = pk2(s[6 * 33], s[7 * 33]);
        *(u32x4*)(WT + (size_t)(n0 + n) * K + k0 + 8 * c) = o; }
    LDS_WAIT(); asm volatile("" ::: "memory");
}
struct SrcPlain { const float* W; int N; FI float operator()(int k, int n) const { return __builtin_nontemporal_load(W + (size_t)k * N + n); } };
struct SrcWin { const float *w_in, *w1, *a1, *g1, *v1, *mu_h, *mu_v; int layer;
    FI float operator()(int k, int n) const {
        if (n < 8192) return __builtin_nontemporal_load(w_in + (size_t)k * NIN + n);
        if (n >= 9216) return __builtin_nontemporal_load(w_in + (size_t)k * NIN + (n - 1024));
        const int j = n - 8192; if (j >= 896) return 0.f;
        const int part = j >= 448 ? 1 : 0; const int jj = part ? j - 448 : j;
        float w, mu;
        if (jj < 128) { const int d = jj >> 6, cc = jj & 63; w = w1[((size_t)d * 1024 + k) * 64 + cc]; mu = mu_h[k]; }
        else if (jj < 256) { const int d = (jj - 128) >> 6, cc = jj & 63; w = a1[((size_t)d * 1024 + k) * 64 + cc]; mu = mu_h[1024 + k]; }
        else if (jj < 416) { w = g1[(size_t)k * 160 + (jj - 256)]; mu = mu_h[2048 + k]; }
        else { if (layer == 0) return 0.f; w = v1[(size_t)k * 32 + (jj - 416)]; mu = mu_v[k]; }
        return part ? w * mu : w * (1.f - mu);
    } };

FI void ph_weights_mixer(const TI& T, int l) {
    LAS float* scr = (LAS float*)(T.lds + T.wave * 16384);
    SrcWin sw; sw.w_in = PIN(8) + (size_t)l * 1024 * NIN; sw.w1 = PIN(20) + (size_t)l * 2 * 1024 * 64; sw.a1 = PIN(23) + (size_t)l * 2 * 1024 * 64;
    sw.g1 = PIN(25) + (size_t)l * 1024 * 160; sw.v1 = PIN(33) + (size_t)(l > 0 ? l - 1 : 0) * 1024 * 32; sw.mu_h = PIN(18) + (size_t)l * 3 * 1024; sw.mu_v = PIN(35) + (size_t)(l > 0 ? l - 1 : 0) * 1024; sw.layer = l;
    bf16* WIN = (bf16*)(PWS + WS_WIN);
    constexpr int I_IN = 16 * 384, I_SQ = 16 * 32;
    for (int it = T.gw; it < I_IN + 4 * I_SQ; it += T.NGW) {
        int r = it;
        if (r < I_IN) { transpose_item(sw, 1024, WIN, (r / 384) * 64, (r % 384) * 32, scr, T.lane); continue; }
        r -= I_IN; const int which = r / I_SQ; r %= I_SQ;
        SrcPlain sp; sp.N = 1024; sp.W = PIN(36 + which) + (size_t)l * 1024 * 1024;
        bf16* WT = which < 3 ? (bf16*)(PWS + WS_WBR) + (size_t)which * 1024 * 1024 : (bf16*)(PWS + WS_WOUT);
        transpose_item(sp, 1024, WT, (r / 32) * 64, (r % 32) * 32, scr, T.lane);
    }
    bf16* WRG = (bf16*)(PWS + WS_WRG);
    for (int i = T.gtid; i < 4096 * 64; i += T.NT) { const int n = i >> 6, d = i & 63, dir = n >> 11, blk = (n >> 7) & 15, hb = (n >> 6) & 1, which = (n >> 5) & 1, e = hb * 32 + (n & 31);
        const float* W = (which ? PIN(14) : PIN(12)) + ((((size_t)l * 2 + dir) * 16 + blk) * 64 + d) * 64 + e; WRG[i] = (bf16)f2bf(*W); }
    for (int i = T.gtid; i < 2048; i += T.NT) ((float*)(PWS + WS_SP8))[i] = 8.f * log1pf(__expf(-PIN(16)[(size_t)l * 2048 + i]));
    bf16* L2 = (bf16*)(PWS + WS_WLR2);
    for (int i = T.gtid; i < 4 * 1024 * 64; i += T.NT) { const int g = i >> 16, n = (i >> 6) & 1023, k = i & 63; const int dir = g & 1;
        const float* W = (g < 2 ? PIN(21) : PIN(24)) + (((size_t)l * 2 + dir) * 64 + k) * 1024 + n; L2[i] = (bf16)f2bf(*W); }
    for (int i = T.gtid; i < 1024 * 160; i += T.NT) { const int n = i / 160, k = i % 160; L2[LR2_G + i] = (bf16)f2bf(PIN(26)[((size_t)l * 160 + k) * 1024 + n]); }
    if (l > 0) for (int i = T.gtid; i < 1024 * 32; i += T.NT) { const int n = i >> 5, k = i & 31; L2[LR2_V + i] = (bf16)f2bf(PIN(34)[((size_t)(l - 1) * 32 + k) * 1024 + n]); }
}
FI void ph_weights_mlp(const TI& T, int l) {
    LAS float* scr = (LAS float*)(T.lds + T.wave * 16384);
    bf16* W1T = (bf16*)(PWS + WS_WIN); bf16* W2T = W1T + (size_t)4096 * 1024;
    for (int it = T.gw; it < 4096; it += T.NGW) {
        if (it < 2048) { SrcPlain sp; sp.N = 4096; sp.W = PIN(40) + (size_t)l * 1024 * 4096; transpose_item(sp, 1024, W1T, (it / 128) * 64, (it % 128) * 32, scr, T.lane); }
        else { const int r = it - 2048; SrcPlain sp; sp.N = 1024; sp.W = PIN(41) + (size_t)l * 4096 * 1024; transpose_item(sp, 4096, W2T, (r / 32) * 64, (r % 32) * 32, scr, T.lane); }
    }
}

FI void ph_norm(const TI& T, int l, int which, bf16* __restrict__ H) {
    const float* __restrict__ gam = PIN(which ? 7 : 6) + l * 1024;
    const float* MODl = (const float*)(PWS + WS_MOD) + (size_t)l * 3 * 6144;
    const bool first = (l == 0 && which == 0);
#pragma unroll 2
    for (int m = T.gw; m < M; m += T.NGW) {
        const float* __restrict__ xr; int s;
        if (m < ML) { xr = (first ? PIN(0) : (const float*)POUT) + (size_t)m * 1024; s = m >> 13; }
        else { xr = (first ? PIN(2) : (const float*)(PWS + WS_XCTX)) + (size_t)(m - ML) * 1024; s = 2; }
        const float* sh = MODl + s * 6144 + (which ? 3072 : 0); const float* sc = sh + 1024;
        f32x4 v[4]; float ss = 0.f;
#pragma unroll
        for (int j = 0; j < 4; ++j) { v[j] = *(const f32x4*)(xr + (64 * j + T.lane) * 4); ss += (v[j][0] * v[j][0] + v[j][1] * v[j][1]) + (v[j][2] * v[j][2] + v[j][3] * v[j][3]); }
        const float rstd = rsqrtf(wave_sum(ss, T.lane) * (1.f / 1024.f) + 1e-6f);
#pragma unroll
        for (int j = 0; j < 4; ++j) { const int cc = (64 * j + T.lane) * 4; const f32x4 g4 = *(const f32x4*)(gam + cc), sc4 = *(const f32x4*)(sc + cc), sh4 = *(const f32x4*)(sh + cc);
            const f32x4 o = (v[j] * rstd * g4) * (1.f + sc4) + sh4; st_bf4(H + (size_t)m * 1024 + cc, o); }
    }
}
FI void ph_final(const TI& T) {
    const float* gam = PIN(42);
    for (int m = T.gw; m < ML; m += T.NGW) {
        float* xr = POUT + (size_t)m * 1024; f32x4 v[4]; float ss = 0.f;
#pragma unroll
        for (int j = 0; j < 4; ++j) { v[j] = *(const f32x4*)(xr + (64 * j + T.lane) * 4); ss += (v[j][0] * v[j][0] + v[j][1] * v[j][1]) + (v[j][2] * v[j][2] + v[j][3] * v[j][3]); }
        const float rstd = rsqrtf(wave_sum(ss, T.lane) * (1.f / 1024.f) + 1e-6f);
#pragma unroll
        for (int j = 0; j < 4; ++j) { const int cc = (64 * j + T.lane) * 4; *(f32x4*)(xr + cc) = v[j] * rstd * *(const f32x4*)(gam + cc); }
    }
}

template <class F> struct Epi {
    static constexpr bool PERM = false, AFTER_DRAIN = false;
    F f;
    FI void operator()(const pg8::f32x4 (&acc)[2][2][4][2], const pg8::Unit& u, int wr, int wc, int fr, int fq) const {
#pragma unroll
        for (int ai = 0; ai < 2; ++ai)
#pragma unroll
            for (int m = 0; m < 4; ++m) { const int row = u.pm * 256 + ai * 128 + wr * 64 + m * 16 + fr;
#pragma unroll
                for (int bj = 0; bj < 2; ++bj) { const int col = u.pn * 256 + bj * 128 + wc * 32 + 4 * fq; f(row, col, acc[ai][bj][m][0], acc[ai][bj][m][1]); }
                asm volatile("" ::: "memory"); }
    }
};
template <class F> FI void run_gemm(const TI& T, const bf16* A, const bf16* Bt, int N, int K, const F& f) {
    pg8::Gemm g{A, Bt, M, N, K}; pg8::StaticOrder S; S.init(M, N, (int)gridDim.x, (int)blockIdx.x);
    Epi<F> E{f};
    pg8::gemm_phase<Epi<F>, pg8::StaticOrder, true, true>((PG8_LAS unsigned char*)T.lds, g, S, E);
}
struct FRw { unsigned char* ws;
    FI void operator()(int row, int col, f32x4 v0, f32x4 v1) const {
        f16* dst = sloth(ws, 1 + (col >> 10)) + (size_t)row * 1024 + (col & 1023); st_h4(dst, v0); st_h4(dst + 16, v1); } };
struct FNat { unsigned char* ws; const float* rope;
    FI void operator()(int row, int col, f32x4 v0, f32x4 v1) const {
        const int sel = col >> 10, cc = col & 1023;
        if (sel < 2) {
            if (row < ML) {
                const int t = row & (SEQ - 1); const int pos = ((cc >> 5) & 1) ? (t & 63) : (t >> 6);
                const float* tp = rope + ((size_t)pos * 16 + (cc & 15)) * 2;
                const f32x4 t0 = *(const f32x4*)tp, t1 = *(const f32x4*)(tp + 4);
                const f32x4 cs = {t0[0], t0[2], t1[0], t1[2]}, sn = {t0[1], t0[3], t1[1], t1[3]};
                const f32x4 o0 = v0 * cs - v1 * sn, o1 = v0 * sn + v1 * cs; v0 = o0; v1 = o1;
            }
            bf16* dst = slotb(ws, 1 + sel) + (size_t)row * 1024 + cc; st_bf4(dst, v0); st_bf4(dst + 16, v1);
        } else {
            const int h = (cc >> 6), d = cc & 63; bf16* vt = slotb(ws, 3); size_t base, stride;
            if (row < ML) { const int b = row >> 13, t = row & (SEQ - 1); stride = SEQ; base = ((size_t)(b * 16 + h) * 64 + d) * SEQ + t; }
            else { const int rr = row - ML, b = rr >> 8, j = rr & 255; stride = CTXL; base = (size_t)ML * 1024 + ((size_t)(b * 16 + h) * 64 + d) * CTXL + j; }
#pragma unroll
            for (int i = 0; i < 4; ++i) { vt[base + i * stride] = (bf16)f2bf(v0[i]); vt[base + (16 + i) * stride] = (bf16)f2bf(v1[i]); }
        }
    } };
FI f32x4 gelu4(f32x4 x) { f32x4 o;
#pragma unroll
    for (int i = 0; i < 4; ++i) { const float u = 0.7978845608f * (x[i] + 0.044715f * x[i] * x[i] * x[i]); o[i] = x[i] * sigmoidf_(2.f * u); } return o; }
FI f32x4 sig4(f32x4 x) { f32x4 o;
#pragma unroll
    for (int i = 0; i < 4; ++i) o[i] = sigmoidf_(x[i]); return o; }
struct FLru { unsigned char* ws;
    FI void operator()(int row, int col, f32x4 v0, f32x4 v1) const {
        const int sel = col >> 10, cc = col & 1023; bf16* dst = slotb(ws, 2 + sel) + (size_t)row * 1024 + cc;
        if (sel) { v0 = gelu4(v0); v1 = gelu4(v1); } st_bf4(dst, v0); st_bf4(dst + 16, v1); } };
struct FGate { unsigned char* ws;
    FI void operator()(int row, int col, f32x4 v0, f32x4 v1) const {
        const int sel = col >> 10, cc = col & 1023; bf16* dst = slotb(ws, sel == 0 ? 2 : (sel == 1 ? 3 : 6)) + (size_t)row * 1024 + cc;
        st_bf4(dst, sig4(v0)); st_bf4(dst + 16, sig4(v1)); } };
template <int KB> struct FBr { const bf16* gate; bf16* mixed;
    FI void operator()(int row, int col, f32x4 v0, f32x4 v1) const {
        const size_t o = (size_t)row * 1024 + col; f32x4 r0 = ld_bf4(gate + o) * v0, r1 = ld_bf4(gate + o + 16) * v1;
        if (KB > 0) { r0 += ld_bf4(mixed + o); r1 += ld_bf4(mixed + o + 16); }
        st_bf4(mixed + o, r0); st_bf4(mixed + o + 16, r1); } };
struct FRes { const float* xl_old; float* xl_new; const float* xc_old; float* xc_new; const float* gt; bool ctx_store;
    FI void operator()(int row, int col, f32x4 v0, f32x4 v1) const {
        const float* xo; float* xn; const float* g;
        if (row < ML) { const size_t o = (size_t)row * 1024 + col; xo = xl_old + o; xn = xl_new + o; g = gt + (row >> 13) * 6144 + col; }
        else { if (!ctx_store) return; const size_t o = (size_t)(row - ML) * 1024 + col; xo = xc_old + o; xn = xc_new + o; g = gt + 2 * 6144 + col; }
        *(f32x4*)xn = *(const f32x4*)xo + *(const f32x4*)g * v0; *(f32x4*)(xn + 16) = *(const f32x4*)(xo + 16) + *(const f32x4*)(g + 16) * v1; } };
struct FFf1 { bf16* hid;
    FI void operator()(int row, int col, f32x4 v0, f32x4 v1) const {
        bf16* dst = hid + (size_t)row * 4096 + col;
#pragma unroll
        for (int i = 0; i < 4; ++i) { const float a = fmaxf(v0[i], 0.f), b = fmaxf(v1[i], 0.f); v0[i] = a * a; v1[i] = b * b; }
        st_bf4(dst, v0); st_bf4(dst + 16, v1); } };

template <int K, int MT, class F>
FI void sgemm_t(const TI& T, const bf16* __restrict__ A, int lda, int acol0, int blkmod, const bf16* __restrict__ Bt, int ncoltiles, const F& f, int blkshift = 0) {
    const int fr = T.lane & 15, fq = T.lane >> 4;
    const int nitems = (M / (16 * MT)) * ncoltiles;
    constexpr int KS = K / 32; constexpr bool PF = (K * MT <= 320);
    bf16x8 af[PF ? KS : 1][MT], bfr[PF ? KS : 1][4];
#define SG_LOAD(it_, ks_, slot_) { const int rt_ = (it_) / ncoltiles, ct_ = (it_) % ncoltiles; const int acol_ = acol0 + (blkmod ? ((ct_ >> blkshift) % blkmod) * 64 : 0); \
        _Pragma("unroll") for (int m = 0; m < MT; ++m) af[slot_][m] = *(const bf16x8*)(A + (size_t)(rt_ * (16 * MT) + 16 * m + fr) * lda + acol_ + (ks_) * 32 + fq * 8); \
        _Pragma("unroll") for (int n = 0; n < 4; ++n) bfr[slot_][n] = *(const bf16x8*)(Bt + (size_t)(ct_ * 64 + 16 * n + fr) * K + (ks_) * 32 + fq * 8); }
    if (PF && T.gw < nitems) {
#pragma unroll
        for (int ks = 0; ks < KS; ++ks) SG_LOAD(T.gw, ks, (PF ? ks : 0));
    }
    for (int it = T.gw; it < nitems; it += T.NGW) {
        const int rt = it / ncoltiles, ct = it % ncoltiles, row0 = rt * (16 * MT);
        typename F::Pre pre[MT];
#pragma unroll
        for (int m = 0; m < MT; ++m) f.pre(pre[m], row0 + 16 * m + fr, ct, fq);
        f32x4 acc[MT][4];
#pragma unroll
        for (int m = 0; m < MT; ++m)
#pragma unroll
            for (int n = 0; n < 4; ++n) acc[m][n] = (f32x4){0.f, 0.f, 0.f, 0.f};
#pragma unroll
        for (int ks = 0; ks < KS; ++ks) {
            if (!PF) SG_LOAD(it, ks, 0);
#pragma unroll
            for (int m = 0; m < MT; ++m)
#pragma unroll
                for (int n = 0; n < 4; ++n) acc[m][n] = __builtin_amdgcn_mfma_f32_16x16x32_bf16(bfr[PF ? ks : 0][n], af[PF ? ks : 0][m], acc[m][n], 0, 0, 0);
        }
        if (PF && it + T.NGW < nitems) {
#pragma unroll
            for (int ks = 0; ks < KS; ++ks) SG_LOAD(it + T.NGW, ks, (PF ? ks : 0));
        }
#pragma unroll
        for (int m = 0; m < MT; ++m) f.row(row0 + 16 * m + fr, ct, fq, acc[m], pre[m]);
        f.tile_done(rt, ct);
    }
#undef SG_LOAD
}
template <int K, class F>
FI void sgemm(const TI& T, const bf16* __restrict__ A, int lda, int acol0, int blkmod, const bf16* __restrict__ Bt, int ncoltiles, const F& f, int blkshift = 0) { sgemm_t<K, 4, F>(T, A, lda, acol0, blkmod, Bt, ncoltiles, f, blkshift); }
struct NoPre {};
#define ROWWISE typedef NoPre Pre; FI void pre(NoPre&, int, int, int) const {} FI void tile_done(int, int) const {} FI void row(int r, int ct, int fq, const f32x4 (&a)[4], const NoPre&) const { _Pragma("unroll") for (int n = 0; n < 4; ++n) (*this)(r, ct * 64 + 16 * n + 4 * fq, a[n]); }
struct FOmw { f16* dst; const float* bias;
    ROWWISE
    FI void operator()(int row, int col, f32x4 v) const { f32x4 o;
#pragma unroll
        for (int i = 0; i < 4; ++i) { const float sg = sigmoidf_(v[i] + bias[col + i]); o[i] = 1.f - __expf(-0.60653066f * sg); }
        st_h4(dst + (size_t)row * 1024 + col, o); } };
struct FSigH { f16* dst; const float* bias;
    ROWWISE
    FI void operator()(int row, int col, f32x4 v) const { f32x4 o;
#pragma unroll
        for (int i = 0; i < 4; ++i) o[i] = sigmoidf_(v[i] + bias[col + i]);
        st_h4(dst + (size_t)row * 1024 + col, o); } };
struct FLr2All { typedef NoPre Pre; FI void pre(NoPre&, int, int, int) const {} FI void tile_done(int, int) const {} unsigned char* ws; const float* w0; const float* a0;
    FI void row(int r, int ct, int fq, const f32x4 (&a)[4], const NoPre&) const {
        const int which = ct >> 4, ctl = ct & 15; const bool dec = which < 2;
        f16* dst = sloth(ws, which == 0 ? 1 : (which == 1 ? 3 : (which == 2 ? 2 : 4))) + (size_t)r * 1024;
        const float* bias = (dec ? w0 : a0) + (which & 1) * 1024;
#pragma unroll
        for (int n = 0; n < 4; ++n) { const int col = ctl * 64 + 16 * n + 4 * fq; f32x4 o;
#pragma unroll
            for (int i = 0; i < 4; ++i) { const float sg = sigmoidf_(a[n][i] + bias[col + i]); o[i] = dec ? 1.f - __expf(-0.60653066f * sg) : sg; }
            st_h4(dst + col, o); }
    } };
struct FVmix { f16* V; const f16* VF; const float* bias;
    ROWWISE
    FI void operator()(int row, int col, f32x4 a) const { const size_t o = (size_t)row * 1024 + col; f32x4 g;
#pragma unroll
        for (int i = 0; i < 4; ++i) g[i] = sigmoidf_(a[i] + bias[col + i]);
        const f32x4 v = ld_h4(V + o), vf = ld_h4(VF + o); st_h4(V + o, v + (vf - v) * g); } };
struct FPlainB { bf16* dst;
    ROWWISE
    FI void operator()(int row, int col, f32x4 v) const { st_bf4(dst + (size_t)row * 1024 + col, v); } };
struct FPost { FI void tile_done(int, int) const {} const bf16* __restrict__ YF; const bf16* __restrict__ YB; const f16* __restrict__ V; bf16* __restrict__ OUT; const float* __restrict__ BS; const float* __restrict__ BS2; const float* __restrict__ lnw; const float* __restrict__ lnb; int lane;
    struct Pre { u32x2 yf[4], yb[4]; f16x4 v[4]; float bs; };
    FI void pre(Pre& p, int r, int ct, int fq) const { const size_t o = (size_t)r * 1024 + ct * 64 + 4 * fq;
#pragma unroll
        for (int n = 0; n < 4; ++n) { p.yf[n] = *(const u32x2*)(YF + o + 16 * n); p.yb[n] = *(const u32x2*)(YB + o + 16 * n); p.v[n] = *(const f16x4*)(V + o + 16 * n); }
        p.bs = BS[(size_t)r * 16 + ct] + BS2[(size_t)r * 16 + ct]; }
    FI void row(int r, int ct, int fq, const f32x4 (&g)[4], const Pre& p) const {
        const size_t o = (size_t)r * 1024 + ct * 64 + 4 * fq; f32x4 y[4], v[4]; float s = 0.f;
#pragma unroll
        for (int n = 0; n < 4; ++n) {
            y[n][0] = bf2f(p.yf[n].x & 0xffffu) + bf2f(p.yb[n].x & 0xffffu); y[n][1] = bf2f(p.yf[n].x >> 16) + bf2f(p.yb[n].x >> 16); y[n][2] = bf2f(p.yf[n].y & 0xffffu) + bf2f(p.yb[n].y & 0xffffu); y[n][3] = bf2f(p.yf[n].y >> 16) + bf2f(p.yb[n].y >> 16);
#pragma unroll
            for (int i = 0; i < 4; ++i) v[n][i] = (float)p.v[n][i];
            s += (y[n][0] + y[n][1]) + (y[n][2] + y[n][3]); }
        const float bsm = p.bs;
        s = sum_fq(s);
        const float mean = s * (1.f / 64.f); float vs = 0.f;
#pragma unroll
        for (int n = 0; n < 4; ++n) { y[n] -= mean; vs += (y[n][0] * y[n][0] + y[n][1] * y[n][1]) + (y[n][2] * y[n][2] + y[n][3] * y[n][3]); }
        vs = sum_fq(vs);
        const float rstd = rsqrtf(vs * (1.f / 64.f) + 64e-5f);
#pragma unroll
        for (int n = 0; n < 4; ++n) { const int cc = ct * 64 + 16 * n + 4 * fq;
            const f32x4 yn = y[n] * rstd * *(const f32x4*)(lnw + cc) + *(const f32x4*)(lnb + cc);
            st_bf4(OUT + o + 16 * n, (yn + bsm * v[n]) * g[n]); }
    } };
struct FRgAB { unsigned char* ws; const float* ba; const float* bx; const float* sp8t; const bf16* UC; int bbslot; LAS f32x2* wl; int lane;
    struct Pre { u32x2 u[2]; };
    FI void pre(Pre& p, int r, int ct, int fq) const { const int blk = (ct >> 1) & 15, hb = ct & 1;
#pragma unroll
        for (int np = 0; np < 2; ++np) p.u[np] = *(const u32x2*)(UC + (size_t)r * 1024 + blk * 64 + hb * 32 + 16 * np + 4 * fq); }
    FI void row(int r, int ct, int fq, const f32x4 (&acc)[4], const Pre& p) const {
        const int dir = ct >> 5, blk = (ct >> 1) & 15, hb = ct & 1;
        f16* OM = sloth(ws, dir ? 2 : 6); f16* BB = sloth(ws, dir ? bbslot : 7);
#pragma unroll
        for (int np = 0; np < 2; ++np) {
            const int ch = blk * 64 + hb * 32 + 16 * np + 4 * fq; const size_t o = (size_t)r * 1024 + ch;
            const f32x4 gr = acc[np] + *(const f32x4*)(ba + dir * 1024 + ch), gi = acc[np + 2] + *(const f32x4*)(bx + dir * 1024 + ch), sp = *(const f32x4*)(sp8t + dir * 1024 + ch); f32x4 u; u[0] = bf2f(p.u[np].x & 0xffffu); u[1] = bf2f(p.u[np].x >> 16); u[2] = bf2f(p.u[np].y & 0xffffu); u[3] = bf2f(p.u[np].y >> 16);
            f32x4 om, bb;
#pragma unroll
            for (int i = 0; i < 4; ++i) { const float rr = sigmoidf_(gr[i]), ii = sigmoidf_(gi[i]), la = -sp[i] * rr; om[i] = 1.f - __expf(la); bb[i] = __builtin_amdgcn_sqrtf(fmaxf(1.f - __expf(2.f * la), 0.f)) * (ii * u[i]); }
            st_h4(OM + o, om); st_h4(BB + o, bb);
#pragma unroll
            for (int i = 0; i < 4; ++i) wl[(r & 63) * 32 + ((16 * np + 4 * fq + i) ^ (r & 15))] = (f32x2){1.f - (float)(f16)om[i], (float)(f16)bb[i]};
        }
    }
    FI void tile_done(int rt, int ct) const {
        LDS_WAIT();
        const int dir = ct >> 5, blk = (ct >> 1) & 15, hb = ct & 1;
        if (lane < 32) {
            float Ap = 1.f, Bp = 0.f;
#pragma unroll 16
            for (int i = 0; i < 64; ++i) { const int rr_ = dir ? 63 - i : i; const f32x2 ab = wl[rr_ * 32 + (lane ^ (rr_ & 15))]; Ap *= ab.x; Bp = ab.x * Bp + ab.y; }
            ((f32x2*)(ws + WS_A2))[((size_t)dir * 264 + rt) * 1024 + blk * 64 + hb * 32 + lane] = (f32x2){Ap, Bp};
        }
        LDS_WAIT();
    } };

FI void ph_shiftmix(const TI& T, int l, int vslot) {
    unsigned char* ws = PWS; const float* __restrict__ mu = PIN(17) + (size_t)l * 3 * 1024;
    bf16* __restrict__ A2 = (bf16*)(ws + WS_A2); const f16* __restrict__ LR = sloth(ws, 4);
    const f16* __restrict__ s0 = sloth(ws, 1); const f16* __restrict__ s1 = sloth(ws, 2); const f16* __restrict__ s2 = sloth(ws, 3);
    f16* __restrict__ d0 = sloth(ws, 5); f16* __restrict__ d1 = sloth(ws, 6); f16* __restrict__ d2 = sloth(ws, vslot);
    const float* __restrict__ kkp = PIN(27) + l * 1024; float* __restrict__ RN = (float*)(ws + WS_RN);
#pragma unroll 4
    for (int it = T.gtid; it < M * 256; it += T.NT) {
        const int m = it >> 8, cc = (it & 255) * 4; int sq0, len, pos; seq_of(m, sq0, len, pos);
        const bool hp = pos > 0, hn = pos < len - 1; const size_t o = (size_t)m * 1024 + cc;
        const size_t op = hp ? o - 1024 : o, on = hn ? o + 1024 : o; const float fp = hp ? 0.5f : 0.f, fn = hn ? 0.5f : 0.f;
        const f32x4 c0 = ld_h4(s0 + o), p0 = ld_h4(s0 + op), n0 = ld_h4(s0 + on), c1 = ld_h4(s1 + o), p1 = ld_h4(s1 + op), n1 = ld_h4(s1 + on), c2 = ld_h4(s2 + o), p2 = ld_h4(s2 + op), n2 = ld_h4(s2 + on);
        const f32x4 m0 = *(const f32x4*)(mu + cc), m1 = *(const f32x4*)(mu + 1024 + cc), m2 = *(const f32x4*)(mu + 2048 + cc);
        const f32x4 ks = c1 + m1 * ((fp * p1 + fn * n1) - c1);
        st_h4(d0 + o, c0 + m0 * ((fp * p0 + fn * n0) - c0)); st_h4(d1 + o, ks); st_h4(d2 + o, c2 + m2 * ((fp * p2 + fn * n2) - c2));
        const f32x4 kq = ks * *(const f32x4*)(kkp + cc); float ss = (kq[0] * kq[0] + kq[1] * kq[1]) + (kq[2] * kq[2] + kq[3] * kq[3]); ss = allred16(ss);
        if ((it & 15) == 0) RN[(size_t)m * 16 + (cc >> 6)] = 1.f / fmaxf(sqrtf(ss), 1e-12f);
    }
#pragma unroll 4
    for (int it = T.gtid; it < M * 112; it += T.NT) {
        const int m = it / 112, jc = (it % 112) * 4; int sq0, len, pos; seq_of(m, sq0, len, pos);
        const bool hp = pos > 0, hn = pos < len - 1; const size_t o = (size_t)m * 1024;
        const size_t op = hp ? o - 1024 : o, on = hn ? o + 1024 : o; const float fp = hp ? 0.5f : 0.f, fn = hn ? 0.5f : 0.f;
        f32x4 u = ld_h4(LR + o + jc); const f32x4 pv = ld_h4(LR + op + 448 + jc), nx = ld_h4(LR + on + 448 + jc);
        u += fp * pv + fn * nx;
        if (jc < 128) {
#pragma unroll
            for (int i = 0; i < 4; ++i) u[i] = 2.f * sigmoidf_(2.f * u[i]) - 1.f;
        } else if (jc >= 256 && jc < 416) u = sig4(u);
        st_bf4(A2 + (size_t)m * 448 + jc, u);
    }
}
FI void ph_rwprep(const TI& T, int l, int vslot) {
    unsigned char* ws = PWS;
    const float* __restrict__ k_k = PIN(27) + l * 1024; const float* __restrict__ k_a = PIN(28) + l * 1024; const float* __restrict__ r_k = PIN(29) + l * 1024;
    float* __restrict__ BS = (float*)(ws + WS_BSUM); float* __restrict__ RN = (float*)(ws + WS_RN);
    const f16* __restrict__ K = sloth(ws, 6); const f16* __restrict__ R = sloth(ws, 5); const f16* __restrict__ AF = sloth(ws, 2); const f16* __restrict__ AB = sloth(ws, 4);
    f16* __restrict__ V = sloth(ws, vslot); const f16* __restrict__ VF = sloth(ws, 8); const f16* __restrict__ VG = sloth(ws, 0);
    const int c0 = T.lane * 16, head = T.lane >> 2;
#pragma unroll 2
    for (int m = T.gw; m < M; m += T.NGW) {
        const size_t o = (size_t)m * 1024 + c0; float ss = 0.f, bs = 0.f;
#pragma unroll
        for (int q = 0; q < 4; ++q) {
            const int cc = c0 + 4 * q; const size_t oo = o + 4 * q;
            const f32x4 k = ld_h4(K + oo), r = ld_h4(R + oo), af = ld_h4(AF + oo), ab = ld_h4(AB + oo);
            const f32x4 kk4 = *(const f32x4*)(k_k + cc), ka4 = *(const f32x4*)(k_a + cc), rk4 = *(const f32x4*)(r_k + cc);
            const f32x4 kq = k * kk4; ss += (kq[0] * kq[0] + kq[1] * kq[1]) + (kq[2] * kq[2] + kq[3] * kq[3]);
            const f32x4 kds = k * (2.f + (af + ab - 2.f) * ka4);
            const f32x4 t = r * kds * rk4; bs += (t[0] + t[1]) + (t[2] + t[3]);
            if (l > 0) { const f32x4 v = ld_h4(V + oo), vf = ld_h4(VF + oo), vg = ld_h4(VG + oo); st_h4(V + oo, v + (vf - v) * vg); }
        }
        ss = quadsum(ss); bs = quadsum(bs);
        if ((T.lane & 3) == 0) { RN[(size_t)m * 16 + head] = 1.f / fmaxf(sqrtf(ss), 1e-12f); BS[(size_t)m * 16 + head] = bs; }
    }
}
FI void ph_rwscan(const TI& T, int l, int vslot, int ybslot) {
    unsigned char* ws = PWS;
    constexpr int GS = 32, NG = (SEQ + CTXL) / GS, REC = 5 * 64 + 16;
    LAS float* ring = (LAS float*)T.lds;
    const float* RN = (const float*)(ws + WS_RN);
    for (int ct = T.vb; ct < 256; ct += gridDim.x) {
        const int chain = ct >> 2, rq = ct & 3, b = chain >> 5, h = (chain >> 1) & 15, dir = chain & 1, hc = h * 64;
        const int cbase = ML + b * CTXL, lbase = b * SEQ;
#define RW_ROW(s) ((s) < CTXL ? (dir ? cbase + CTXL - 1 - (s) : cbase + (s)) : (dir ? lbase + SEQ - 1 - ((s) - CTXL) : lbase + ((s) - CTXL)))
        if (T.wave >= 4) {
            const int pw = T.wave - 4, lane = T.lane;
            const f16* Rp = sloth(ws, 5) + hc + lane; const f16* Kp = sloth(ws, 6) + hc + lane; const f16* Vp = sloth(ws, vslot) + hc + rq * 16 + (lane & 15);
            const f16* Op = sloth(ws, dir ? 3 : 1) + hc + lane; const f16* Ap = sloth(ws, dir ? 4 : 2) + hc + lane;
            const float kkc = PIN(27)[l * 1024 + hc + lane], kac = PIN(28)[l * 1024 + hc + lane], rkc = PIN(29)[l * 1024 + hc + lane];
            float* __restrict__ BSd = (float*)(ws + (dir ? WS_BSB : WS_BSUM));
            f16 cr[8], ck[8], co[8], ca[8], cv[8]; float crn[8];
            f16 nr[8], nk[8], no[8], na[8], nv[8]; float nrn[8];
#define RW_LOAD(R_, K_, O_, A_, V_, N_, g_) { _Pragma("unroll") for (int u = 0; u < 8; ++u) { const int mm = RW_ROW((g_) * GS + pw * 8 + u); const size_t ro = (size_t)mm * 1024; \
                R_[u] = Rp[ro]; K_[u] = Kp[ro]; O_[u] = Op[ro]; A_[u] = Ap[ro]; V_[u] = Vp[ro]; N_[u] = RN[(size_t)mm * 16 + h]; } }
#define RW_CONV(R_, K_, O_, A_, V_, N_, buf_, g_) { _Pragma("unroll") for (int u = 0; u < 8; ++u) { LAS float* rec = ring + ((buf_) * GS + pw * 8 + u) * REC; \
                const float k = (float)K_[u], a = (float)A_[u]; const float kk = k * (kkc * N_[u]); const float kd = k * (1.f + (a - 1.f) * kac), rr = (float)R_[u]; \
                rec[lane] = kk; rec[64 + lane] = -(kk * a); rec[128 + lane] = kd; rec[192 + lane] = 1.f - (float)O_[u]; rec[256 + lane] = rr; if (lane < 16) rec[320 + lane] = (float)V_[u]; \
                if (rq == 0) { const float bs = wave_sum(rr * kd * rkc, lane); if (lane == 0) BSd[(size_t)RW_ROW((g_) * GS + pw * 8 + u) * 16 + h] = bs; } } }
            RW_LOAD(cr, ck, co, ca, cv, crn, 0);
            RW_CONV(cr, ck, co, ca, cv, crn, 0, 0);
            RW_LOAD(cr, ck, co, ca, cv, crn, 1);
            __syncthreads();
            for (int g = 0; g < NG; ++g) {
                if (g + 2 < NG) RW_LOAD(nr, nk, no, na, nv, nrn, g + 2);
                if (g + 1 < NG) RW_CONV(cr, ck, co, ca, cv, crn, (g + 1) & 1, g + 1);
#pragma unroll
                for (int u = 0; u < 8; ++u) { cr[u] = nr[u]; ck[u] = nk[u]; co[u] = no[u]; ca[u] = na[u]; cv[u] = nv[u]; crn[u] = nrn[u]; }
                __syncthreads();
            }
#undef RW_LOAD
#undef RW_CONV
        } else {
            const int vl = T.wave * 4 + (T.lane >> 4), kq = (T.lane & 15) * 4;
            GAS bf16* Yp = (GAS bf16*)(slotb(ws, dir ? ybslot : 0) + hc + rq * 16 + vl);
            const bool wr = (T.lane & 15) == 0;
            f32x4 S = {0.f, 0.f, 0.f, 0.f};
            __syncthreads();
            for (int g = 0; g < NG; ++g) {
                const LAS float* rec = ring + ((g & 1) * GS) * REC;
                const int m0 = RW_ROW(g * GS); const long ystep = dir ? -1024 : 1024;
                GAS bf16* yp = Yp + (size_t)m0 * 1024;
                f32x4 kk[3], bb[3], kd[3], w[3], r[3]; float v[3];
#define RW_LDREC(j_, s_) { const LAS float* q_ = rec + (s_) * REC; kk[j_] = *(const LAS f32x4*)(q_ + kq); bb[j_] = *(const LAS f32x4*)(q_ + 64 + kq); kd[j_] = *(const LAS f32x4*)(q_ + 128 + kq); \
                    w[j_] = *(const LAS f32x4*)(q_ + 192 + kq); r[j_] = *(const LAS f32x4*)(q_ + 256 + kq); v[j_] = q_[320 + vl]; }
                RW_LDREC(0, 0); RW_LDREC(1, 1);
                const int lb0 = T.lane & 1, lb1 = (T.lane >> 1) & 1;
                const long yoff = (long)(lb1 + 2 * lb0) * ystep;
                const bool wr4 = (T.lane & 15) < 4;
                float p[4];
#pragma unroll
                for (int si = 0; si < GS; ++si) {
                    if (si + 2 < GS) RW_LDREC((si + 2) % 3, si + 2);
                    const int j = si % 3;
                    float d = (S[0] * kk[j][0] + S[1] * kk[j][1]) + (S[2] * kk[j][2] + S[3] * kk[j][3]);
                    const f32x4 base = S * w[j] + v[j] * kd[j];
                    d = allred16(d);
                    S = base + d * bb[j];
                    p[si & 3] = (S[0] * r[j][0] + S[1] * r[j][1]) + (S[2] * r[j][2] + S[3] * r[j][3]);
                    if ((si & 3) == 3) {
                        float kA = lb0 ? p[2] : p[0], sA = lb0 ? p[0] : p[2], kB = lb0 ? p[3] : p[1], sB = lb0 ? p[1] : p[3];
                        kA += dppf<0xB1>(sA); kB += dppf<0xB1>(sB);
                        float kC = lb1 ? kB : kA, sC = lb1 ? kA : kB;
                        kC += dppf<0x4E>(sC);
                        kC += dppf<0x124>(kC); kC += dppf<0x128>(kC);
                        if (wr4) yp[yoff] = (bf16)f2bf(kC);
                        yp += 4 * ystep;
                    }
                }
#undef RW_LDREC
                __syncthreads();
            }
        }
#undef RW_ROW
        __syncthreads();
    }
}
FI void ph_rwpost(const TI& T, int l, int vslot, int ybslot) {
    unsigned char* ws = PWS; const float* __restrict__ lnw = PIN(30) + l * 1024; const float* __restrict__ lnb = PIN(31) + l * 1024; const float* __restrict__ BS = (const float*)(ws + WS_BSUM);
    const bf16* __restrict__ YF = slotb(ws, 0); const bf16* __restrict__ YB = slotb(ws, ybslot); const f16* __restrict__ V = sloth(ws, vslot); const bf16* __restrict__ G = slotb(ws, 1); bf16* __restrict__ OUT = slotb(ws, 5);
    const int c0 = T.lane * 16, head = T.lane >> 2;
#pragma unroll 2
    for (int m = T.gw; m < M; m += T.NGW) {
        const size_t o = (size_t)m * 1024 + c0; f32x4 y[4], v[4], g[4]; float s = 0.f;
#pragma unroll
        for (int q = 0; q < 4; ++q) { y[q] = ld_bf4(YF + o + 4 * q) + ld_bf4(YB + o + 4 * q); v[q] = ld_h4(V + o + 4 * q); g[q] = ld_bf4(G + o + 4 * q); s += (y[q][0] + y[q][1]) + (y[q][2] + y[q][3]); }
        const float bsm = BS[(size_t)m * 16 + head];
        const float mean = quadsum(s) * (1.f / 64.f); float vs = 0.f;
#pragma unroll
        for (int q = 0; q < 4; ++q) { y[q] -= mean; vs += (y[q][0] * y[q][0] + y[q][1] * y[q][1]) + (y[q][2] * y[q][2] + y[q][3] * y[q][3]); }
        const float rstd = rsqrtf(quadsum(vs) * (1.f / 64.f) + 64e-5f);
#pragma unroll
        for (int q = 0; q < 4; ++q) { const int cc = c0 + 4 * q;
            const f32x4 yn = y[q] * rstd * *(const f32x4*)(lnw + cc) + *(const f32x4*)(lnb + cc);
            st_bf4(OUT + o + 4 * q, (yn + bsm * v[q]) * g[q]); }
    }
}

FI void ph_natten(const TI& T, int l, bool ctx_out) {
    unsigned char* ws = PWS; const bf16* Q = slotb(ws, 1); const bf16* Kb = slotb(ws, 2); const bf16* Vt = slotb(ws, 3); bf16* Y = slotb(ws, 1);
    const int fr = T.lane & 15, fq = T.lane >> 4, w = T.wave, tid = T.tid;
    LAS unsigned char* Kl = T.lds; LAS unsigned char* Vl = T.lds + 9216;
    const int ntasks = 1024 + (ctx_out ? 32 : 0);
    const int lrow = tid >> 3, lpc = tid & 7;
    for (int task = T.vb; task < ntasks; task += gridDim.x) {
        const bool cq = task >= 1024; int b, h, r = 0, half = 0, qrow0, U0, nwin;
        if (!cq) { const int rg = task & 31; h = (task >> 5) & 15; b = task >> 9; r = rg * 4 + (w >> 1); half = w & 1; qrow0 = b * SEQ + r * 64 + half * 32;
                   U0 = min(max(rg * 4 - 4, 0), 120); nwin = min(max(rg * 4 + 3 - 4, 0), 120) + 8 - U0; }
        else { const int t2 = task - 1024; h = t2 & 15; b = t2 >> 4; qrow0 = ML + b * CTXL + w * 32; U0 = 0; nwin = 0; }
        const int nch = nwin + 4; const int r0 = min(max(r - 4, 0), 120);
        const float* rpb = PIN(9) + ((size_t)l * 16 + h) * 15 * 31;
        LAS float* RL = (LAS float*)(T.lds + 18432);
        __syncthreads();
        if (tid < 465) RL[tid] = rpb[tid];
        bf16x8 Qf[2][2];
#pragma unroll
        for (int qt = 0; qt < 2; ++qt)
#pragma unroll
            for (int ks = 0; ks < 2; ++ks) Qf[qt][ks] = *(const bf16x8*)(Q + (size_t)(qrow0 + qt * 16 + fr) * 1024 + h * 64 + ks * 32 + fq * 8);
        f32x4 O[2][4]; float mr[2], lr[2];
#pragma unroll
        for (int qt = 0; qt < 2; ++qt) { mr[qt] = -1e30f; lr[qt] = 0.f;
#pragma unroll
            for (int dt = 0; dt < 4; ++dt) O[qt][dt] = (f32x4){0.f, 0.f, 0.f, 0.f}; }
#define NAT_GLOAD(c_, kreg_, vreg_) { const bool w_ = (c_) < nwin; const int kr_ = U0 + (c_), cc_ = (c_) - nwin; \
            const bf16* kp_ = w_ ? Kb + (size_t)(b * SEQ + kr_ * 64 + lrow) * 1024 + h * 64 + lpc * 8 : Kb + (size_t)(ML + b * CTXL + cc_ * 64 + lrow) * 1024 + h * 64 + lpc * 8; \
            const bf16* vp_ = w_ ? Vt + ((size_t)(b * 16 + h) * 64 + lrow) * SEQ + kr_ * 64 + lpc * 8 : Vt + (size_t)ML * 1024 + ((size_t)(b * 16 + h) * 64 + lrow) * CTXL + cc_ * 64 + lpc * 8; \
            kreg_ = *(const u32x4*)kp_; vreg_ = *(const u32x4*)vp_; }
        u32x4 kreg, vreg;
        NAT_GLOAD(0, kreg, vreg);
        for (int c = 0; c < nch; ++c) {
            __syncthreads();
            *(LAS u32x4*)(Kl + lrow * 144 + lpc * 16) = kreg; *(LAS u32x4*)(Vl + lrow * 144 + lpc * 16) = vreg;
            __syncthreads();
            if (c + 1 < nch) NAT_GLOAD(c + 1, kreg, vreg);
            const bool win = c < nwin; const int kr = U0 + c;
            const bool active = win ? (kr >= r0 && kr < r0 + 8) : true;
            if (active) {
                f32x4 s[2][4];
                const int ktskip = win ? (half ? 0 : 3) : -1;
#pragma unroll
                for (int kt = 0; kt < 4; ++kt) {
                    if (kt == ktskip) { s[0][kt] = (f32x4){-1e30f, -1e30f, -1e30f, -1e30f}; s[1][kt] = s[0][kt]; continue; }
                    const bf16x8 k0 = *(const LAS bf16x8*)(Kl + (kt * 16 + fr) * 144 + fq * 16), k1 = *(const LAS bf16x8*)(Kl + (kt * 16 + fr) * 144 + 64 + fq * 16);
#pragma unroll
                    for (int qt = 0; qt < 2; ++qt) { f32x4 a = {0.f, 0.f, 0.f, 0.f}; a = __builtin_amdgcn_mfma_f32_16x16x32_bf16(k0, Qf[qt][0], a, 0, 0, 0); a = __builtin_amdgcn_mfma_f32_16x16x32_bf16(k1, Qf[qt][1], a, 0, 0, 0); s[qt][kt] = a; }
                }
                bf16x8 Pf[2][2];
#pragma unroll
                for (int qt = 0; qt < 2; ++qt) {
                    float mx = -1e30f;
                    if (win) {
                        const int qcol = half * 32 + qt * 16 + fr, c0 = min(max(qcol - 8, 0), 48); const LAS float* rp = RL + (kr - r + 7) * 31;
                        const int tl = fq * 4 - c0, dl = fq * 4 - qcol + 15;
#pragma unroll
                        for (int kt = 0; kt < 4; ++kt) {
                            if (kt == ktskip) continue;
#pragma unroll
                            for (int j = 0; j < 4; ++j) { const int t = (kt * 16 + j) + tl; const int oob = (t | (15 - t)) >> 31;
                                const int dc = min(max((kt * 16 + j) + dl, 0), 30); const float val = s[qt][kt][j] * 0.125f + rp[dc];
                                const float mval = __builtin_bit_cast(float, (__builtin_bit_cast(int, val) & ~oob) | (0xf149f2ca & oob));
                                s[qt][kt][j] = mval; mx = fmaxf(mx, mval); }
                        }
                    } else {
#pragma unroll
                        for (int kt = 0; kt < 4; ++kt)
#pragma unroll
                            for (int j = 0; j < 4; ++j) { const float val = s[qt][kt][j] * 0.125f; s[qt][kt][j] = val; mx = fmaxf(mx, val); }
                    }
                    mx = max_fq(mx);
                    const float mnew = fmaxf(mr[qt], mx), alpha = __expf(mr[qt] - mnew); mr[qt] = mnew; float ps = 0.f;
#pragma unroll
                    for (int kt = 0; kt < 4; ++kt)
#pragma unroll
                        for (int j = 0; j < 4; ++j) { const float p = __expf(s[qt][kt][j] - mnew); s[qt][kt][j] = p; ps += p; }
                    lr[qt] = lr[qt] * alpha + ps;
#pragma unroll
                    for (int dt = 0; dt < 4; ++dt) O[qt][dt] *= alpha;
#pragma unroll
                    for (int s2 = 0; s2 < 2; ++s2) { u32x4 pw; pw.x = pk2(s[qt][2 * s2][0], s[qt][2 * s2][1]); pw.y = pk2(s[qt][2 * s2][2], s[qt][2 * s2][3]); pw.z = pk2(s[qt][2 * s2 + 1][0], s[qt][2 * s2 + 1][1]); pw.w = pk2(s[qt][2 * s2 + 1][2], s[qt][2 * s2 + 1][3]);
                        Pf[qt][s2] = __builtin_bit_cast(bf16x8, pw); }
                }
#pragma unroll
                for (int dt = 0; dt < 4; ++dt)
#pragma unroll
                    for (int s2 = 0; s2 < 2; ++s2) {
                        const LAS unsigned char* vp = Vl + (dt * 16 + fr) * 144 + (2 * s2 * 16 + fq * 4) * 2;
                        const u32x2 lo = *(const LAS u32x2*)vp, hi = *(const LAS u32x2*)(vp + 32);
                        u32x4 vw; vw.x = lo.x; vw.y = lo.y; vw.z = hi.x; vw.w = hi.y; const bf16x8 Vf = __builtin_bit_cast(bf16x8, vw);
#pragma unroll
                        for (int qt = 0; qt < 2; ++qt) O[qt][dt] = __builtin_amdgcn_mfma_f32_16x16x32_bf16(Vf, Pf[qt][s2], O[qt][dt], 0, 0, 0);
                    }
            }
        }
#undef NAT_GLOAD
#pragma unroll
        for (int qt = 0; qt < 2; ++qt) { float lt = sum_fq(lr[qt]); const float inv = 1.f / lt;
#pragma unroll
            for (int dt = 0; dt < 4; ++dt) st_bf4(Y + (size_t)(qrow0 + qt * 16 + fr) * 1024 + h * 64 + dt * 16 + fq * 4, O[qt][dt] * inv); }
    }
}

FI void ph_conv(const TI& T, int l) {
    unsigned char* ws = PWS; const float* __restrict__ cw = PIN(10) + (size_t)l * 4 * 1024; const float* __restrict__ cb = PIN(11) + l * 1024;
    const bf16* __restrict__ U = slotb(ws, 2); bf16* __restrict__ UC = slotb(ws, 4);
#pragma unroll 4
    for (int it = T.gtid; it < M * 256; it += T.NT) {
        const int m = it >> 8, cc = (it & 255) * 4; int s0, len, pos; seq_of(m, s0, len, pos);
        f32x4 acc = *(const f32x4*)(cb + cc);
#pragma unroll
        for (int j = 0; j < 4; ++j) { const int pp = pos + j - 2; const bool ok = pp >= 0 && pp < len; const f32x4 x = ld_bf4(U + (size_t)(s0 + (ok ? pp : pos)) * 1024 + cc); acc += (ok ? 1.f : 0.f) * (*(const f32x4*)(cw + j * 1024 + cc) * x); }
        st_bf4(UC + (size_t)m * 1024 + cc, acc);
    }
}
typedef _Float16 f16x2 __attribute__((ext_vector_type(2)));
FI void ph_rgscan1(const TI& T, int l) {
    unsigned char* ws = PWS; f32x2* __restrict__ AB = (f32x2*)(ws + WS_A2);
    for (int it = T.gtid; it < 2 * 264 * 512; it += T.NT) {
        const int c = (it & 511) * 2, q = (it >> 9) % 264, dir = it / (264 * 512);
        const f16* __restrict__ OM = sloth(ws, dir ? 2 : 6); const f16* __restrict__ BB = sloth(ws, dir ? (l == 0 ? 0 : 8) : 7);
        float Ap0 = 1.f, Bp0 = 0.f, Ap1 = 1.f, Bp1 = 0.f;
#pragma unroll 16
        for (int i = 0; i < 64; ++i) { const int m = q * 64 + (dir ? 63 - i : i); const size_t o = (size_t)m * 1024 + c; const f16x2 om = *(const f16x2*)(OM + o), b = *(const f16x2*)(BB + o);
            const float a0 = 1.f - (float)om[0], a1 = 1.f - (float)om[1]; Ap0 *= a0; Bp0 = a0 * Bp0 + (float)b[0]; Ap1 *= a1; Bp1 = a1 * Bp1 + (float)b[1]; }
        const size_t oi = ((size_t)dir * 264 + q) * 1024 + c; AB[oi] = (f32x2){Ap0, Bp0}; AB[oi + 1] = (f32x2){Ap1, Bp1};
    }
}
FI void ph_rgscan2(const TI& T) {
    unsigned char* ws = PWS; const f32x2* AB = (const f32x2*)(ws + WS_A2); float* HIN = (float*)(ws + WS_A2 + (size_t)2 * 264 * 1024 * 8);
    for (int it = T.gtid; it < 4096; it += T.NT) {
        const int c = it & 1023, b = (it >> 10) & 1, dir = it >> 11; float h = 0.f;
        for (int i0 = 0; i0 < 132; i0 += 33) {
            f32x2 ab[33]; int qq[33];
#pragma unroll
            for (int u = 0; u < 33; ++u) { const int i = i0 + u; int q; if (i < 4) q = 256 + b * 4 + (dir ? 3 - i : i); else q = b * 128 + (dir ? 127 - (i - 4) : (i - 4)); qq[u] = q; ab[u] = AB[((size_t)dir * 264 + q) * 1024 + c]; }
#pragma unroll
            for (int u = 0; u < 33; ++u) { HIN[((size_t)dir * 264 + qq[u]) * 1024 + c] = h; h = ab[u].x * h + ab[u].y; }
        }
    }
}
FI void ph_rgscan3(const TI& T, int l) {
    unsigned char* ws = PWS; const float* __restrict__ HIN = (const float*)(ws + WS_A2 + (size_t)2 * 264 * 1024 * 8);
    bf16* __restrict__ UC = slotb(ws, 4); const bf16* __restrict__ GUG = slotb(ws, 3);
    const f16* __restrict__ OMF = sloth(ws, 6); const f16* __restrict__ BBF = sloth(ws, 7); const f16* __restrict__ OMB = sloth(ws, 2); const f16* __restrict__ BBB = sloth(ws, l == 0 ? 0 : 8);
    for (int it = T.gtid; it < 264 * 512; it += T.NT) {
        const int c = (it & 511) * 2, q = it >> 9; const size_t ob = (size_t)(q * 64) * 1024 + c;
        unsigned hfr[64];
        float h0 = HIN[((size_t)0 * 264 + q) * 1024 + c], h1 = HIN[((size_t)0 * 264 + q) * 1024 + c + 1];
#define RS3_F(I0) { f16x2 om[16], b[16]; \
            _Pragma("unroll") for (int u = 0; u < 16; ++u) { om[u] = *(const f16x2*)(OMF + ob + (size_t)((I0) + u) * 1024); b[u] = *(const f16x2*)(BBF + ob + (size_t)((I0) + u) * 1024); } \
            _Pragma("unroll") for (int u = 0; u < 16; ++u) { h0 = (h0 - (float)om[u][0] * h0) + (float)b[u][0]; h1 = (h1 - (float)om[u][1] * h1) + (float)b[u][1]; hfr[(I0) + u] = pk2(h0, h1); } }
        RS3_F(0) RS3_F(16) RS3_F(32) RS3_F(48)
#undef RS3_F
        h0 = HIN[((size_t)1 * 264 + q) * 1024 + c]; h1 = HIN[((size_t)1 * 264 + q) * 1024 + c + 1];
#define RS3_B(I0) { f16x2 om[16], b[16]; unsigned gg[16]; \
            _Pragma("unroll") for (int u = 0; u < 16; ++u) { const size_t o = ob + (size_t)(63 - (I0) - u) * 1024; om[u] = *(const f16x2*)(OMB + o); b[u] = *(const f16x2*)(BBB + o); gg[u] = *(const unsigned*)(GUG + o); } \
            _Pragma("unroll") for (int u = 0; u < 16; ++u) { const size_t o = ob + (size_t)(63 - (I0) - u) * 1024; const unsigned hf = hfr[63 - (I0) - u]; \
                h0 = (h0 - (float)om[u][0] * h0) + (float)b[u][0]; h1 = (h1 - (float)om[u][1] * h1) + (float)b[u][1]; \
                *(unsigned*)(UC + o) = pk2((bf2f(hf & 0xffffu) + h0) * bf2f(gg[u] & 0xffffu), (bf2f(hf >> 16) + h1) * bf2f(gg[u] >> 16)); } }
        RS3_B(0) RS3_B(16) RS3_B(32) RS3_B(48)
#undef RS3_B
    }
}

enum { G_RW = 0, G_NAT, G_LRU, G_GATE, G_BRA, G_BRB, G_BRC, G_OUT, G_FF1, G_FF2 };
struct EpiAll {
    static constexpr bool PERM = false, AFTER_DRAIN = false;
    int mode, l; LAS unsigned char* lds;
    FI void one(unsigned char* ws, float* out, const float* x_in, const float* ctx_in, int row, int col, f32x4 v0, f32x4 v1) const {
        const float* MODl_ = (const float*)(ws + WS_MOD) + (size_t)l * 3 * 6144;
        switch (mode) {
            case G_RW: FRw{ws}(row, col, v0, v1); break;
            case G_NAT: FNat{ws, (const float*)(ws + WS_ROPE)}(row, col, v0, v1); break;
            case G_LRU: FLru{ws}(row, col, v0, v1); break;
            case G_GATE: FGate{ws}(row, col, v0, v1); break;
            case G_BRA: FBr<0>{slotb(ws, 2), slotb(ws, 7)}(row, col, v0, v1); break;
            case G_BRB: FBr<1>{slotb(ws, 3), slotb(ws, 7)}(row, col, v0, v1); break;
            case G_BRC: FBr<2>{slotb(ws, 6), slotb(ws, 7)}(row, col, v0, v1); break;
            case G_OUT: FRes{l == 0 ? x_in : (const float*)out, out, l == 0 ? ctx_in : (const float*)(ws + WS_XCTX), (float*)(ws + WS_XCTX), MODl_ + 2048, l == 0}(row, col, v0, v1); break;
            case G_FF1: FFf1{slotb(ws, 1)}(row, col, v0, v1); break;
            default: FRes{(const float*)out, out, (const float*)(ws + WS_XCTX), (float*)(ws + WS_XCTX), MODl_ + 5120, l == 0}(row, col, v0, v1); break;
        }
    }
    FI void operator()(const pg8::f32x4 (&acc)[2][2][4][2], const pg8::Unit& u, int wr, int wc, int fr, int fq) const {
        unsigned char* ws = (unsigned char*)ldsptr(lds, 44); float* out = (float*)ldsptr(lds, 43); const float* x_in = ldsptr(lds, 0); const float* ctx_in = ldsptr(lds, 2);
#pragma unroll
        for (int ai = 0; ai < 2; ++ai)
#pragma unroll
            for (int m = 0; m < 4; ++m) { const int row = u.pm * 256 + ai * 128 + wr * 64 + m * 16 + fr;
#pragma unroll
                for (int bj = 0; bj < 2; ++bj) { const int col = u.pn * 256 + bj * 128 + wc * 32 + 4 * fq; one(ws, out, x_in, ctx_in, row, col, acc[ai][bj][m][0], acc[ai][bj][m][1]); }
                asm volatile("" ::: "memory"); }
    }
};
FI void run_gemm_all(const TI& T, int mode, int l) {
    unsigned char* ws = PWS;
    int aslot = 0, N = 1024, K = 1024; size_t boff = WS_WIN;
    switch (mode) {
        case G_RW: boff = WS_WIN + (size_t)5120 * 2048; N = 4096; break;
        case G_NAT: N = 3072; break;
        case G_LRU: boff = WS_WIN + (size_t)3072 * 2048; N = 2048; break;
        case G_GATE: boff = WS_WIN + (size_t)9216 * 2048; N = 3072; break;
        case G_BRA: aslot = 1; boff = WS_WBR; break;
        case G_BRB: aslot = 4; boff = WS_WBR + (size_t)1024 * 2048; break;
        case G_BRC: aslot = 5; boff = WS_WBR + (size_t)2048 * 2048; break;
        case G_OUT: aslot = 7; boff = WS_WOUT; break;
        case G_FF1: N = 4096; break;
        default: aslot = 1; boff = WS_WIN + (size_t)4096 * 2048; K = 4096; break;
    }
    const bf16* Abase = (l == 0 && mode <= G_GATE) ? (const bf16*)POUT : slotb(ws, aslot);
    pg8::Gemm g{Abase, (const bf16*)(ws + boff), ML, N, K}; pg8::StaticOrder S; S.init(ML, N, (int)gridDim.x, (int)blockIdx.x);
    EpiAll E{mode, l, T.lds};
    pg8::gemm_phase<EpiAll, pg8::StaticOrder, true, true>((PG8_LAS unsigned char*)T.lds, g, S, E);
    if (l == 1 && mode >= G_GATE) return;
    {
        const bf16* A = Abase + (size_t)ML * K; const bf16* Bt = (const bf16*)(ws + boff);
        const int fr = T.lane & 15, fq = T.lane >> 4, nct = N >> 6, nitems = 8 * nct, kw = K >> 3;
        LAS float* red = (LAS float*)T.lds;
        unsigned char* ws2 = ws; float* out = POUT; const float* x_in = PIN(0); const float* ctx_in = PIN(2);
        for (int it = T.vb; it < nitems; it += gridDim.x) {
            const int rt = it / nct, ct = it % nct, row0 = rt * 64, col0 = ct * 64, kbeg = T.wave * kw;
            f32x4 acc[4][4];
#pragma unroll
            for (int m = 0; m < 4; ++m)
#pragma unroll
                for (int n = 0; n < 4; ++n) acc[m][n] = (f32x4){0.f, 0.f, 0.f, 0.f};
            for (int k0 = kbeg; k0 < kbeg + kw; k0 += 128) {
                bf16x8 af[4][4], bfr[4][4];
#pragma unroll
                for (int ks = 0; ks < 4; ++ks) {
#pragma unroll
                    for (int m = 0; m < 4; ++m) af[ks][m] = *(const bf16x8*)(A + (size_t)(row0 + 16 * m + fr) * K + k0 + ks * 32 + fq * 8);
#pragma unroll
                    for (int n = 0; n < 4; ++n) bfr[ks][n] = *(const bf16x8*)(Bt + (size_t)(col0 + 16 * n + fr) * K + k0 + ks * 32 + fq * 8);
                }
#pragma unroll
                for (int ks = 0; ks < 4; ++ks)
#pragma unroll
                    for (int m = 0; m < 4; ++m)
#pragma unroll
                        for (int n = 0; n < 4; ++n) acc[m][n] = __builtin_amdgcn_mfma_f32_16x16x32_bf16(bfr[ks][n], af[ks][m], acc[m][n], 0, 0, 0);
            }
            { LAS float* dst = red + T.wave * 4096 + T.lane;
#pragma unroll
              for (int m = 0; m < 4; ++m)
#pragma unroll
                  for (int n = 0; n < 4; ++n)
#pragma unroll
                      for (int j = 0; j < 4; ++j) dst[((m * 4 + n) * 4 + j) * 64] = acc[m][n][j]; }
            __syncthreads();
            { const int m = T.wave >> 1, np = T.wave & 1; f32x4 s0 = {0.f, 0.f, 0.f, 0.f}, s1 = {0.f, 0.f, 0.f, 0.f};
#pragma unroll
              for (int w = 0; w < 8; ++w) { const LAS float* src = red + w * 4096 + T.lane;
#pragma unroll
                  for (int j = 0; j < 4; ++j) { s0[j] += src[((m * 4 + 2 * np) * 4 + j) * 64]; s1[j] += src[((m * 4 + 2 * np + 1) * 4 + j) * 64]; } }
              E.one(ws2, out, x_in, ctx_in, ML + row0 + 16 * m + fr, col0 + 32 * np + 4 * fq, s0, s1); }
            __syncthreads();
        }
    }
}

#define XB_TMO      128
#define XB_XCNT(j)  (256  + 64 * (j))
#define XB_XSUB(j)  (1280 + 64 * (j))
#define XB_XGEN(j)  (2304 + 64 * (j))
#define XB_TOP      3328
#define XB_TOPGEN   3392
#define XCD_BAR_WORDS 3456
#define XB_SPIN_CAP (1u << 18)

__device__ __forceinline__ unsigned xb_ld(unsigned* p)              { return __hip_atomic_load(p, __ATOMIC_RELAXED, __HIP_MEMORY_SCOPE_AGENT); }
__device__ __forceinline__ unsigned xb_add(unsigned* p, unsigned v) { return __hip_atomic_fetch_add(p, v, __ATOMIC_RELAXED, __HIP_MEMORY_SCOPE_AGENT); }
__device__ __forceinline__ unsigned xb_xcc_id() { return (unsigned)__builtin_amdgcn_s_getreg((3 << 11) | 20) & 0xFu; }
#define XB_SPIN(cond, bar) do { unsigned _sp = 0; while (cond) { __builtin_amdgcn_s_sleep(1); \
    if ((++_sp & 255u) == 0u) { if (xb_ld(&(bar)[XB_TMO])) break; if (_sp > XB_SPIN_CAP) { atomicAdd(&(bar)[XB_TMO], 1u); break; } } } } while (0)

struct XcdBarrier {
    unsigned* bar; unsigned x;
    volatile LAS unsigned* st;
};

__device__ __forceinline__ XcdBarrier xcd_barrier_post(unsigned* bar, volatile LAS unsigned* st) {
    XcdBarrier b; b.bar = bar; b.x = xb_xcc_id(); b.st = st;
    if (threadIdx.x == 0) (void)xb_add(&bar[XB_XCNT(b.x)], 1u);
    return b;
}
__device__ __forceinline__ void xcd_barrier_complete(unsigned* bar, unsigned x, unsigned& nloc, unsigned& nx) {
    const unsigned G = gridDim.x * gridDim.y * gridDim.z;
    unsigned sum, cnt, mine, sp = 0u;
    for (;;) {
        sum = 0u; cnt = 0u; mine = 0u;
#pragma unroll
        for (unsigned j = 0; j < 16; ++j) { const unsigned c = xb_ld(&bar[XB_XCNT(j)]); sum += c; cnt += (c > 0u) ? 1u : 0u; mine = (j == x) ? c : mine; }
        if (sum == G) break;
        __builtin_amdgcn_s_sleep(1);
        if ((++sp & 255u) == 0u) { if (xb_ld(&bar[XB_TMO])) break; if (sp > XB_SPIN_CAP) { atomicAdd(&bar[XB_TMO], 1u); break; } }
    }
    nloc = mine > 0u ? mine : 1u; nx = cnt > 0u ? cnt : 1u;
}

__device__ __forceinline__ void xcd_barrier(const XcdBarrier& b) {
    asm volatile("s_waitcnt vmcnt(0)" ::: "memory");
    __syncthreads();
    if (threadIdx.x == 0) {
        unsigned* bar = b.bar;
        __builtin_amdgcn_s_waitcnt(0);
        unsigned nloc = b.st[0], nx = b.st[1];
        if (nloc == 0u) { xcd_barrier_complete(bar, b.x, nloc, nx); b.st[0] = nloc; b.st[1] = nx; }
        const unsigned old = xb_add(&bar[XB_XSUB(b.x)], 1u);
        const unsigned gen = old / nloc;
        if (old + 1u == (gen + 1u) * nloc) {
            __builtin_amdgcn_fence(__ATOMIC_RELEASE, "agent");
            asm volatile("s_waitcnt vmcnt(0)" ::: "memory");
            const unsigned og = xb_add(&bar[XB_TOP], 1u);
            const unsigned tg = og / nx;
            if (og + 1u == (tg + 1u) * nx) xb_add(&bar[XB_TOPGEN], 1u);
            else XB_SPIN(xb_ld(&bar[XB_TOPGEN]) == tg, bar);
            __builtin_amdgcn_fence(__ATOMIC_ACQUIRE, "agent");
            xb_add(&bar[XB_XGEN(b.x)], 1u);
            asm volatile("s_waitcnt vmcnt(0)" ::: "memory");
        } else {
            XB_SPIN(xb_ld(&bar[XB_XGEN(b.x)]) == gen, bar);
            __builtin_amdgcn_fence(__ATOMIC_ACQUIRE, "agent");
            asm volatile("s_waitcnt vmcnt(0)" ::: "memory");
        }
    }
    __syncthreads();
}

enum { P_MOD = 0, P_PREP, P_SHIFT, P_LR2, P_RWPREP, P_SCAN, P_GG, P_RWPOST, P_NORM1, P_NAT, P_CONV, P_RGG, P_RS1, P_RS2, P_RS3, P_NORM2W, P_FINAL, P_NOP, P_GEMM0   };
#define PG(g) (P_GEMM0 + (g))
#define NOSYNC 64
#ifndef PROBE_EXTRA
#define PROBE_EXTRA(L)
#endif
#ifndef PB_NAT
#define PB_NAT(L)
#endif
#ifndef PB_GRW
#define PB_GRW(L)
#endif
#ifndef PB_SMALL1
#define PB_SMALL1(L)
#define PB_SMALL2(L)
#define PB_SMALL3(L)
#endif
#ifndef DUPP
#define DUPP(x)
#endif
#ifndef DUPG
#define DUPG(x)
#endif
#ifndef DUPS
#define DUPS(x)
#endif
#ifndef DUPA
#define DUPA(x)
#endif
#ifndef DUPC
#define DUPC(x)
#endif
#ifndef DUPB
#define DUPB(x)
#endif
#ifndef DUP
#define DUP(x)
#endif
#define NORM1A(L) NORM1A_##L
#define NORM1A_0
#define NORM1A_32 32 | P_NORM1,
#define LAYER(L) (L) | P_PREP, DUPP((L) | P_PREP) (L) | PG(G_RW), PB_GRW(L) (L) | P_SHIFT, DUPA((L) | P_SHIFT) (L) | P_LR2, DUPB((L) | P_LR2) (L) | P_SCAN, DUPS((L) | P_SCAN) (L) | P_RWPOST, DUPA((L) | P_RWPOST) NORM1A(L) (L) | PG(G_NAT), (L) | P_NAT, PB_NAT(L) \
    (L) | PG(G_LRU), (L) | P_CONV, DUPA((L) | P_CONV) (L) | P_RGG, DUPB((L) | P_RGG) (L) | P_RS2, DUPC((L) | P_RS2) (L) | P_RS3, (L) | PG(G_GATE), (L) | PG(G_BRA) | NOSYNC, DUPG((L) | PG(G_BRA) | NOSYNC) (L) | PG(G_BRB) | NOSYNC, (L) | PG(G_BRC), \
    (L) | PG(G_OUT), (L) | P_NORM2W, DUPP((L) | P_NORM2W) (L) | PG(G_FF1), (L) | PG(G_FF2), PROBE_EXTRA(L)
__constant__ unsigned char PROG[] = { P_MOD, LAYER(0) LAYER(32) 32 | P_FINAL };

__global__ void __launch_bounds__(NTHR, 2) mega(Params P) {
    extern __shared__ __attribute__((aligned(16))) unsigned char lds_raw[];
    cg::grid_group grid = cg::this_grid();
    LAS unsigned char* const lds0 = (LAS unsigned char*)lds_raw;
    { const int tid0 = threadIdx.x;
      LAS unsigned* tb = (LAS unsigned*)(lds0 + 131072);
      if (tid0 < 43) { const unsigned long long v = (unsigned long long)P.in[tid0]; tb[2 * tid0] = (unsigned)v; tb[2 * tid0 + 1] = (unsigned)(v >> 32); }
      if (tid0 == 43) { const unsigned long long v = (unsigned long long)P.out; tb[86] = (unsigned)v; tb[87] = (unsigned)(v >> 32); }
      if (tid0 == 44) { const unsigned long long v = (unsigned long long)P.ws; tb[88] = (unsigned)v; tb[89] = (unsigned)(v >> 32); } }
    { LAS unsigned* tb = (LAS unsigned*)(lds0 + 131072); if (threadIdx.x == 64) { tb[256] = 0u; tb[257] = 0u; } }
    __syncthreads();
    XcdBarrier xbar = xcd_barrier_post((unsigned*)(P.ws + WS_BAR), (volatile LAS unsigned*)(lds0 + 131072 + 1024));
    constexpr int NSTEPS = (int)sizeof(PROG);
    for (int st = 0; st < NSTEPS; ++st) {
        const unsigned code = PROG[st]; const int op = code & 31, l = (code >> 5) & 1;
        {
            const TI T = mk_ti(lds0);
            const int vslot = l == 0 ? 8 : 7, ybslot = l == 0 ? 7 : 8;
            unsigned char* ws = PWS;
            const bf16* L2 = (const bf16*)(ws + WS_WLR2); const bf16* A2 = (const bf16*)(ws + WS_A2);
            switch (op) {
                case P_MOD: ph_mod(T); break;
                case P_PREP: ph_weights_mixer(T, l); ph_norm(T, l, 0, l == 0 ? (bf16*)POUT : slotb(ws, 0)); break;
                case P_SHIFT: ph_shiftmix(T, l, vslot); break;
                case P_LR2:
                    sgemm<64>(T, A2, 448, 0, 4, L2 + LR2_ZF, 64, FLr2All{ws, PIN(19) + (size_t)l * 2048, PIN(22) + (size_t)l * 2048}, 4);
                    if (l > 0) sgemm_t<32, 2>(T, A2, 448, 416, 0, L2 + LR2_V, 16, FVmix{sloth(ws, vslot), sloth(ws, 8), PIN(32) + (l - 1) * 1024});
                    break;
                case P_RWPREP: ph_rwprep(T, l, vslot); break;
                case P_SCAN: ph_rwscan(T, l, vslot, ybslot); break;
                case P_GG: sgemm<160>(T, A2, 448, 256, 0, L2 + LR2_G, 16, FPlainB{slotb(ws, 1)}); break;
                case P_RWPOST: sgemm_t<160, 2>(T, A2, 448, 256, 0, L2 + LR2_G, 16, FPost{slotb(ws, 0), slotb(ws, ybslot), sloth(ws, vslot), slotb(ws, 5), (const float*)(ws + WS_BSUM), (const float*)(ws + WS_BSB), PIN(30) + l * 1024, PIN(31) + l * 1024, T.lane}); break;
                case P_NORM1: ph_norm(T, l, 0, slotb(ws, 0)); break;
                case P_NAT: ph_natten(T, l, l == 0); break;
                case P_CONV: ph_conv(T, l); break;
                case P_RGG: sgemm<64>(T, slotb(ws, 4), 1024, 0, 16, (const bf16*)(ws + WS_WRG), 64, FRgAB{ws, PIN(13) + (size_t)l * 2048, PIN(15) + (size_t)l * 2048, (const float*)(ws + WS_SP8), slotb(ws, 4), l == 0 ? 0 : 8, (LAS f32x2*)(T.lds + T.wave * 16384), T.lane}, 1); break;
                case P_RS1: ph_rgscan1(T, l); break;
                case P_RS2: ph_rgscan2(T); break;
                case P_RS3: ph_rgscan3(T, l); break;
                case P_NORM2W: ph_norm(T, l, 1, slotb(ws, 0)); ph_weights_mlp(T, l); break;
                case P_FINAL: ph_final(T); break;
                case P_NOP: break;
                default: run_gemm_all(T, op - P_GEMM0, l); break;
            }
        }
        if (!(code & NOSYNC) && st + 1 < NSTEPS) { if (P.ph_lo == 0x7fffffff) grid.sync();
            else { XcdBarrier b2; b2.bar = (unsigned*)(ldsptr(lds0, 44)) + WS_BAR / 4; b2.x = xb_xcc_id(); b2.st = (volatile LAS unsigned*)(lds0 + 131072 + 1024); xcd_barrier(b2); } }
    }
}

extern "C" void kernel_launch(void* const* d_in, const int* in_sizes, int n_in, void* d_out, int out_size, void* d_ws, size_t ws_size, hipStream_t stream) {
    static int grid = 0;
    if (grid == 0) {
        if (n_in != 43 || out_size != ML * 1024 || ws_size < WS_END) { fprintf(stderr, "kernel_launch: unexpected problem (n_in %d, out %d, ws %zu < %zu)\n", n_in, out_size, ws_size, (size_t)WS_END); grid = -1; return; }
        int dev = 0, cus = 0, per_cu = 0;
        (void)hipGetDevice(&dev); (void)hipDeviceGetAttribute(&cus, hipDeviceAttributeMultiprocessorCount, dev);
        if (hipFuncSetAttribute((const void*)mega, hipFuncAttributeMaxDynamicSharedMemorySize, LDS_BYTES) != hipSuccess) { fprintf(stderr, "kernel_launch: hipFuncSetAttribute failed\n"); grid = -1; return; }
        if (hipOccupancyMaxActiveBlocksPerMultiprocessor(&per_cu, (const void*)mega, NTHR, LDS_BYTES) != hipSuccess || per_cu < 1) { fprintf(stderr, "kernel_launch: occupancy query says %d\n", per_cu); grid = -1; return; }
        grid = cus;
    }
    if (grid < 0) return;
    Params p{};
    for (int i = 0; i < 43; ++i) p.in[i] = (const float*)d_in[i];
    p.out = (float*)d_out; p.ws = (unsigned char*)d_ws; p.ph_lo = 0; p.ph_hi = 1000;
    if (hipMemsetAsync((char*)d_ws + WS_BAR, 0, 16384, stream) != hipSuccess) { fprintf(stderr, "kernel_launch: memset failed\n"); return; }
    void* args[] = {&p};
    hipError_t e = hipLaunchCooperativeKernel((const void*)mega, dim3(grid), dim3(NTHR), args, LDS_BYTES, stream);
    if (e != hipSuccess) fprintf(stderr, "cooperative launch failed: %s (grid %d)\n", hipGetErrorString(e), grid);
}
```
